# Optimizing an MI355X kernel written in HIP

```python
import functools
import jax, jax.numpy as jnp
from jax import lax
import numpy as np

D_MODEL = 2048
BATCH = 4
SEQ = 8192
DEPTH = 1
DEC_BATCH = 32
DEC_SEQ = 64
PAST_LEN = 4096

CHUNK = 64
N_PREV_CHUNKS = 8
BAND = N_PREV_CHUNKS * CHUNK
N_HEADS = 8
HEAD_DIM = 128
ATTN_WIDTH = N_HEADS * HEAD_DIM
CONV_CH = D_MODEL - ATTN_WIDTH
MIX_WIDTH = ATTN_WIDTH + CONV_CH
IN_WIDTH = 3 * ATTN_WIDTH + 3 * CONV_CH
REL_CLIP = 128
CONV_K = 3
N_MEM = 256
X_HEADS = 4
X_HEAD_DIM = 256
X_WIDTH = X_HEADS * X_HEAD_DIM
D_FF = 5632
EPS = 1e-6
NEG_INF = -1e30

kernel_name = "hybrid_streaming_encoder_step"


def rms_norm(x, g):
    xf = x.astype(jnp.float32)
    y = xf * lax.rsqrt(jnp.mean(xf * xf, axis=-1, keepdims=True) + EPS)
    return y.astype(x.dtype) * g


def causal_dwconv(x, prev, w):
    T = x.shape[1]
    xp = jnp.concatenate([prev.astype(x.dtype), x], axis=1)
    y = xp[:, 0:T] * w[0]
    for kk in range(1, CONV_K):
        y = y + xp[:, kk:kk + T] * w[kk]
    return y, xp[:, T:]


def rel_bias_lookup(table, dist):
    return table[:, jnp.clip(dist, -REL_CLIP, REL_CLIP) + REL_CLIP].astype(jnp.float32)


def biased_softmax(s, bias, valid):
    s = s.astype(jnp.float32) * (HEAD_DIM ** -0.5) + bias
    if valid is not None:
        s = jnp.where(valid, s, NEG_INF)
    return jax.nn.softmax(s, axis=-1)


def prompt_band_attention(q, k, v, table, keep):
    B, S = q.shape[:2]
    nc = S // CHUNK
    nb = N_PREV_CHUNKS + 1
    pad = ((0, 0), (BAND, 0), (0, 0), (0, 0))
    kp = jnp.pad(k, pad).reshape(B, nc + N_PREV_CHUNKS, CHUNK, N_HEADS, HEAD_DIM)
    vp = jnp.pad(v, pad).reshape(B, nc + N_PREV_CHUNKS, CHUNK, N_HEADS, HEAD_DIM)
    qc = q.reshape(B, nc, CHUNK, N_HEADS, HEAD_DIM)
    s = jnp.concatenate(
        [jnp.einsum("bcqhd,bckhd->bchqk", qc, kp[:, w:w + nc]) for w in range(nb)], axis=-1)
    qi = jnp.arange(CHUNK)
    kj = jnp.arange(nb * CHUNK)
    dist = BAND + qi[:, None] - kj[None, :]
    key_chunk = jnp.arange(nc)[:, None] - N_PREV_CHUNKS + (kj // CHUNK)[None, :]
    valid = (key_chunk >= 0)[None, :, None, None, :]
    p = biased_softmax(s, rel_bias_lookup(table, dist), valid).astype(v.dtype)
    p = p.reshape(B, nc, N_HEADS, CHUNK, nb, CHUNK)
    o = jnp.einsum("bchqk,bckhd->bcqhd", p[:, :, :, :, 0], vp[:, 0:nc])
    for w in range(1, nb):
        o = o + jnp.einsum("bchqk,bckhd->bcqhd", p[:, :, :, :, w], vp[:, w:w + nc])
    return (o.reshape(B, S, ATTN_WIDTH), k[:, S - keep:], v[:, S - keep:])


def sample_band_attention(q, k, v, cache_k, cache_v, table):
    B, T = q.shape[:2]
    L = cache_k.shape[1]
    k_all = jnp.concatenate([cache_k.astype(k.dtype), k], axis=1)
    v_all = jnp.concatenate([cache_v.astype(v.dtype), v], axis=1)
    dist = L + jnp.arange(T)[:, None] - jnp.arange(L + T)[None, :]
    s = jnp.einsum("bqhd,bkhd->bhqk", q, k_all)
    p = biased_softmax(s, rel_bias_lookup(table, dist), None).astype(v.dtype)
    o = jnp.einsum("bhqk,bkhd->bqhd", p, v_all)
    return (o.reshape(B, T, ATTN_WIDTH), k_all[:, T:], v_all[:, T:])


def memory_kv(mem, g_mem_norm, w_xkv, g_xk):
    B, M, _ = mem.shape
    mk, mv = jnp.split(rms_norm(mem, g_mem_norm) @ w_xkv, 2, axis=-1)
    mk = rms_norm(mk.reshape(B, M, X_HEADS, X_HEAD_DIM), g_xk)
    return mk, mv.reshape(B, M, X_HEADS, X_HEAD_DIM)


def cross_attention(h, mem_k, mem_v, g_norm2, w_xq, g_xq, w_xo):
    B, T, _ = h.shape
    q = rms_norm((rms_norm(h, g_norm2) @ w_xq).reshape(B, T, X_HEADS, X_HEAD_DIM), g_xq)
    s = jnp.einsum("bqhd,bkhd->bhqk", q, mem_k.astype(q.dtype)).astype(jnp.float32)
    p = jax.nn.softmax(s * (X_HEAD_DIM ** -0.5), axis=-1).astype(h.dtype)
    o = jnp.einsum("bhqk,bkhd->bqhd", p, mem_v.astype(h.dtype))
    return o.reshape(B, T, X_WIDTH) @ w_xo


def encoder_layer(x, band_fn, conv_prev, ffn_prev, mem_k, mem_v,
                  g_norm1, w_in, g_q, g_k, w_conv_mix, g_out_attn, g_out_conv, w_out,
                  g_norm2, w_xq, g_xq, w_xo, g_norm3, w_up, w_gate, w_ffn_conv, w_down):
    B, T, _ = x.shape
    n = rms_norm(x, g_norm1)
    cuts = [ATTN_WIDTH, 2 * ATTN_WIDTH, 3 * ATTN_WIDTH,
            3 * ATTN_WIDTH + CONV_CH, 3 * ATTN_WIDTH + 2 * CONV_CH]
    q, k, v, b_gate, c_gate, u = jnp.split(n @ w_in, cuts, axis=-1)
    q = rms_norm(q.reshape(B, T, N_HEADS, HEAD_DIM), g_q)
    k = rms_norm(k.reshape(B, T, N_HEADS, HEAD_DIM), g_k)
    v = v.reshape(B, T, N_HEADS, HEAD_DIM)
    a_out, new_k, new_v = band_fn(q, k, v)
    c_conv, new_conv = causal_dwconv(c_gate * u, conv_prev, w_conv_mix)
    mixed = jnp.concatenate([rms_norm(a_out, g_out_attn),
                             rms_norm(b_gate * c_conv, g_out_conv)], axis=-1)
    h = x + mixed @ w_out
    h = h + cross_attention(h, mem_k, mem_v, g_norm2, w_xq, g_xq, w_xo)
    n3 = rms_norm(h, g_norm3)
    up, new_ffn = causal_dwconv(n3 @ w_up, ffn_prev, w_ffn_conv)
    y = h + (jax.nn.silu(up) * (n3 @ w_gate)) @ w_down
    return y, new_k, new_v, new_conv, new_ffn


def setup_inputs(seed: int = 0) -> dict:
    key = jax.random.key(seed)
    ks = iter(jax.random.split(key, 40))

    def nrm(shape, scale=1.0):
        return scale * jax.random.normal(next(ks), shape, jnp.float32)

    def gain(shape):
        return 1.0 + nrm(shape, 0.02)

    L = min(BAND, PAST_LEN)
    return {
        "x_prompt": nrm((BATCH, SEQ, D_MODEL)),
        "x_sample": nrm((DEC_BATCH, DEC_SEQ, D_MODEL)),
        "mem_prompt": nrm((BATCH, N_MEM, D_MODEL)),
        "cache_attn_k": nrm((DEPTH, DEC_BATCH, L, N_HEADS, HEAD_DIM)),
        "cache_attn_v": nrm((DEPTH, DEC_BATCH, L, N_HEADS, HEAD_DIM)),
        "cache_conv": nrm((DEPTH, DEC_BATCH, CONV_K - 1, CONV_CH)),
        "cache_ffn_conv": nrm((DEPTH, DEC_BATCH, CONV_K - 1, D_FF)),
        "cache_mem_k": nrm((DEPTH, DEC_BATCH, N_MEM, X_HEADS, X_HEAD_DIM)),
        "cache_mem_v": nrm((DEPTH, DEC_BATCH, N_MEM, X_HEADS, X_HEAD_DIM)),
        "g_norm1": gain((DEPTH, D_MODEL)),
        "w_in": nrm((DEPTH, D_MODEL, IN_WIDTH), D_MODEL ** -0.5),
        "g_q": gain((DEPTH, HEAD_DIM)),
        "g_k": gain((DEPTH, HEAD_DIM)),
        "rel_bias": nrm((DEPTH, N_HEADS, 2 * REL_CLIP + 1), 0.1),
        "w_conv_mix": nrm((DEPTH, CONV_K, CONV_CH), CONV_K ** -0.5),
        "g_out_attn": gain((DEPTH, ATTN_WIDTH)),
        "g_out_conv": gain((DEPTH, CONV_CH)),
        "w_out": nrm((DEPTH, MIX_WIDTH, D_MODEL), MIX_WIDTH ** -0.5),
        "g_norm2": gain((DEPTH, D_MODEL)),
        "g_mem_norm": gain((DEPTH, D_MODEL)),
        "w_xq": nrm((DEPTH, D_MODEL, X_WIDTH), D_MODEL ** -0.5),
        "w_xkv": nrm((DEPTH, D_MODEL, 2 * X_WIDTH), D_MODEL ** -0.5),
        "g_xq": gain((DEPTH, X_HEAD_DIM)),
        "g_xk": gain((DEPTH, X_HEAD_DIM)),
        "w_xo": nrm((DEPTH, X_WIDTH, D_MODEL), X_WIDTH ** -0.5),
        "g_norm3": gain((DEPTH, D_MODEL)),
        "w_up": nrm((DEPTH, D_MODEL, D_FF), D_MODEL ** -0.5),
        "w_gate": nrm((DEPTH, D_MODEL, D_FF), D_MODEL ** -0.5),
        "w_ffn_conv": nrm((DEPTH, CONV_K, D_FF), CONV_K ** -0.5),
        "w_down": nrm((DEPTH, D_FF, D_MODEL), D_FF ** -0.5),
    }


def reference(x_prompt, x_sample, mem_prompt, cache_attn_k, cache_attn_v, cache_conv,
              cache_ffn_conv, cache_mem_k, cache_mem_v, g_norm1, w_in, g_q, g_k, rel_bias,
              w_conv_mix, g_out_attn, g_out_conv, w_out, g_norm2, g_mem_norm, w_xq, w_xkv,
              g_xq, g_xk, w_xo, g_norm3, w_up, w_gate, w_ffn_conv, w_down):
    Bp, Sp, _ = x_prompt.shape
    keep = min(BAND, Sp)
    yp, ys = x_prompt, x_sample
    p_k, p_v, p_c, p_f, p_mk, p_mv = [], [], [], [], [], []
    s_k, s_v, s_c, s_f = [], [], [], []
    for l in range(DEPTH):
        layer_w = (g_norm1[l], w_in[l], g_q[l], g_k[l], w_conv_mix[l], g_out_attn[l],
                   g_out_conv[l], w_out[l], g_norm2[l], w_xq[l], g_xq[l], w_xo[l],
                   g_norm3[l], w_up[l], w_gate[l], w_ffn_conv[l], w_down[l])
        mk_p, mv_p = memory_kv(mem_prompt, g_mem_norm[l], w_xkv[l], g_xk[l])
        prompt_band = functools.partial(prompt_band_attention, table=rel_bias[l], keep=keep)
        zc = jnp.zeros((Bp, CONV_K - 1, CONV_CH), yp.dtype)
        zf = jnp.zeros((Bp, CONV_K - 1, D_FF), yp.dtype)
        yp, pk, pv, pc, pf = encoder_layer(yp, prompt_band, zc, zf, mk_p, mv_p, *layer_w)
        sample_band = functools.partial(sample_band_attention, cache_k=cache_attn_k[l],
                                        cache_v=cache_attn_v[l], table=rel_bias[l])
        ys, sk, sv, sc, sf = encoder_layer(ys, sample_band, cache_conv[l], cache_ffn_conv[l],
                                           cache_mem_k[l], cache_mem_v[l], *layer_w)
        p_k.append(pk); p_v.append(pv); p_c.append(pc); p_f.append(pf)
        p_mk.append(mk_p); p_mv.append(mv_p)
        s_k.append(sk); s_v.append(sv); s_c.append(sc); s_f.append(sf)
    return (yp, ys,
            jnp.stack(p_k), jnp.stack(p_v), jnp.stack(p_c), jnp.stack(p_f),
            jnp.stack(p_mk), jnp.stack(p_mv),
            jnp.stack(s_k), jnp.stack(s_v), jnp.stack(s_c), jnp.stack(s_f))
```

```cpp
#include <hip/hip_runtime.h>
#include <hip/hip_cooperative_groups.h>
#include <cstdio>
#include <cstdint>
namespace cg = cooperative_groups;

#define LAS __attribute__((address_space(3)))
typedef unsigned short bf16_t;
typedef short bf16x8 __attribute__((ext_vector_type(8)));
typedef short s16x4 __attribute__((ext_vector_type(4)));
typedef float f32x4 __attribute__((ext_vector_type(4)));
typedef float f32x2 __attribute__((ext_vector_type(2)));
typedef float f32x16 __attribute__((ext_vector_type(16)));
typedef unsigned u32x4 __attribute__((ext_vector_type(4)));
typedef unsigned u32x2 __attribute__((ext_vector_type(2)));
typedef __bf16 bf16x2_t __attribute__((ext_vector_type(2)));

constexpr int DM = 2048, NPR = 32768, MT = 34816, DFF = 5632, SEQ = 8192;
constexpr float EPS = 1e-6f, LOG2E = 1.4426950408889634f;
constexpr int KROWS = NPR + 32 * 576;

constexpr size_t MiB = 1u << 20;
constexpr size_t WS_SSA = 1 * MiB, WS_SSB = 3 * MiB, WS_SS2 = 4 * MiB, WS_SS3 = 6 * MiB;
constexpr size_t WS_WUG = 16 * MiB, WS_WDN = 60 * MiB;
constexpr size_t WS_XN = 82 * MiB, WS_HB = 82 * MiB, WS_H2B = 82 * MiB;
constexpr size_t WS_QB = 218 * MiB, WS_KA = 286 * MiB, WS_VA = 386 * MiB, WS_BB = 486 * MiB, WS_CB = 554 * MiB, WS_UB = 622 * MiB;
constexpr size_t WS_MIX = 698 * MiB;
constexpr size_t WS_QX = 218 * MiB, WS_XO = 286 * MiB;
constexpr size_t WS_UP = 218 * MiB, WS_GATE = 592 * MiB;
constexpr size_t WS_TAIL = 966 * MiB, WS_HEADU = 974 * MiB, WS_HEADG = 982 * MiB;
constexpr size_t WS_MEMN = 926 * MiB, WS_MKA = 930 * MiB, WS_MVA = 948 * MiB;
constexpr size_t WS_WIN = 966 * MiB, WS_WOUT = 990 * MiB, WS_WXQ = 998 * MiB, WS_WXKV = 1002 * MiB, WS_WXO = 1010 * MiB, WS_END = 1014 * MiB;

constexpr int RING_BYTES = 131072, XCH_OFF = 131072, BT_OFF = XCH_OFF + 8192, LSC_OFF = BT_OFF + 8 * 264 * 4, MISC_OFF = LSC_OFF + 8 * 32 * 4, LDS_BYTES = 153600;
static_assert(MISC_OFF + 64 <= LDS_BYTES, "lds map");

__device__ __forceinline__ unsigned cvtpk(float lo, float hi) { f32x2 v = {lo, hi}; bf16x2_t b = __builtin_convertvector(v, bf16x2_t); return __builtin_bit_cast(unsigned, b); }
__device__ __forceinline__ unsigned f2bf(float f) { unsigned u = __builtin_bit_cast(unsigned, f); return (u + 0x7fffu + ((u >> 16) & 1u)) >> 16; }
__device__ __forceinline__ float bflo(unsigned w) { return __builtin_bit_cast(float, w << 16); }
__device__ __forceinline__ float bfhi(unsigned w) { return __builtin_bit_cast(float, w & 0xffff0000u); }
__device__ __forceinline__ float wave_sum(float v) {
#pragma unroll
    for (int o = 1; o < 64; o <<= 1) v += __shfl_xor(v, o);
    return v;
}
__device__ __forceinline__ float wave_max(float v) {
#pragma unroll
    for (int o = 1; o < 64; o <<= 1) v = fmaxf(v, __shfl_xor(v, o));
    return v;
}
__device__ __forceinline__ u32x4 pack8(f32x4 a, f32x4 b) { u32x4 w; w.x = cvtpk(a[0], a[1]); w.y = cvtpk(a[2], a[3]); w.z = cvtpk(b[0], b[1]); w.w = cvtpk(b[2], b[3]); return w; }

constexpr int BM = 256, BK = 64, HALF = 128, HTB = HALF * BK * 2, NXCD = 8, WGM = 4;
__device__ __forceinline__ int lds_byte(int r, int c) { const int st = (r >> 4) * 2 + (c >> 5), rr = r & 15, cc = c & 31, ob = rr * 64 + cc * 2; return st * 1024 + (ob ^ (((ob >> 9) & 1) << 5)); }
__device__ __forceinline__ void stage_rc(int b, int& R, int& C) { const int st = b / 1024, sb = b % 1024, swz = sb ^ (((sb >> 9) & 1) << 5); R = (st >> 1) * 16 + swz / 64; C = (st & 1) * 32 + (swz % 64) / 2; }
__device__ __forceinline__ int perm32(int rho) { const int n = rho >> 4, i = rho & 15; return 8 * (i >> 2) + 4 * n + (i & 3); }

struct Unit { int pm, pn, gid, ks, tail; };
struct Order {
    int nM, nN, nwg, G, c, nex, exN, nfull, nsplit;
    __device__ __forceinline__ void init(int M, int N, int G_, int c_, int exM = 0, int exN_ = 1, int nfull_ = -1, int nsplit_ = 1) { nM = M / BM; nN = N / BM; nwg = nM * nN; G = G_; c = c_; exN = exN_; nex = (exM / BM) * exN_;
        nfull = nfull_ < 0 ? nwg : nfull_; nsplit = nsplit_; }
    __device__ __forceinline__ void map(int wgid, int& pm, int& pn) const {
        { const int q = nwg / NXCD, r = nwg % NXCD, xcd = wgid % NXCD, off = wgid / NXCD; wgid = (xcd < r ? xcd * (q + 1) : r * (q + 1) + (xcd - r) * q) + off; }
        const int nig = WGM * nN, gidx = wgid / nig, fm = gidx * WGM, gsz = (nM - fm) < WGM ? (nM - fm) : WGM;
        pm = fm + ((wgid % nig) % gsz); pn = (wgid % nig) / gsz;
    }
    __device__ __forceinline__ bool next(int i, Unit& u) const {
        const int L = i * G + c, nmain = nfull + (nwg - nfull) * nsplit; const bool ok = L < nmain + nex; const bool ex = L >= nmain;
        const int e = ex ? L - nmain : 0;
        const bool sp = !ex && L >= nfull; const int es = sp ? L - nfull : 0;
        const int wgid = ex ? 0 : (sp ? nfull + es / nsplit : L);
        int pm0, pn0; map(wgid, pm0, pn0);
        u.pm = ex ? e / exN : pm0; u.pn = ex ? e % exN : pn0; u.gid = ex ? 1 : 0; u.ks = sp ? es % nsplit : -1; u.tail = sp ? es / nsplit : 0;
        return ok;
    }
};

#define EPI_BAR() do { asm volatile("s_waitcnt lgkmcnt(0)" ::: "memory"); __builtin_amdgcn_s_barrier(); asm volatile("" ::: "memory"); } while (0)

__device__ __forceinline__ void head_ss(const f32x4 (&v)[2][2][4][2], float (&tot)[2][4][2], LAS float* X, int wr, int wc, int fr, int fq) {
#pragma unroll
    for (int ai = 0; ai < 2; ++ai)
#pragma unroll
        for (int m = 0; m < 4; ++m)
#pragma unroll
            for (int bj = 0; bj < 2; ++bj) {
                const f32x4 a = v[ai][bj][m][0], b = v[ai][bj][m][1];
                float s = (a[0] * a[0] + a[1] * a[1]) + (a[2] * a[2] + a[3] * a[3]) + (b[0] * b[0] + b[1] * b[1]) + (b[2] * b[2] + b[3] * b[3]);
                s += __shfl_xor(s, 16); s += __shfl_xor(s, 32);
                if (fq == 0) X[((ai * 128 + wr * 64 + m * 16 + fr) * 2 + bj) * 4 + wc] = s;
            }
    EPI_BAR();
#pragma unroll
    for (int ai = 0; ai < 2; ++ai)
#pragma unroll
        for (int m = 0; m < 4; ++m)
#pragma unroll
            for (int bj = 0; bj < 2; ++bj) { const f32x4 t = *(const LAS f32x4*)(X + ((ai * 128 + wr * 64 + m * 16 + fr) * 2 + bj) * 4); tot[ai][m][bj] = (t[0] + t[1]) + (t[2] + t[3]); }
}

template <class Epi>
__device__ __forceinline__ void gemm_phase(LAS unsigned char* lds, const bf16_t* A0, const bf16_t* B0, const bf16_t* A1, const bf16_t* B1, const int K, const Order& S, const Epi& E) {
    const int tid = threadIdx.x, wid = __builtin_amdgcn_readfirstlane(tid >> 6), lane = tid & 63, wr = wid >> 2, wc = wid & 3, fr = lane & 15, fq = lane >> 4;
    const int nt = K / BK;
    unsigned voffA[2], voffB[2];
#pragma unroll
    for (int i = 0; i < 2; ++i) { int R, C; stage_rc(tid * 16 + i * 8192, R, C); const int Rb = (R & ~31) + perm32(R & 31);
        voffA[i] = (unsigned)(R * K + C) * 2u; voffB[i] = (unsigned)(Rb * K + C) * 2u; }
    const size_t kstep = (size_t)(BK * 2);
    const size_t hstep = (size_t)HALF * K * 2;
    const size_t tstep = 2 * hstep;
    const unsigned ldsw = (unsigned)wid * 1024u;
    const int aoff = lds_byte(wr * 64 + fr, fq * 8), boff = lds_byte(wc * 32 + fr, fq * 8);
#define PG8_SA(b, h) (((b) * 2 + (h)) * HTB)
#define PG8_SB(b, h) ((4 + (b) * 2 + (h)) * HTB)
#define PG8_STAGE(bufoff, gbase, voff) do { _Pragma("unroll") for (int _i = 0; _i < 2; ++_i) \
        __builtin_amdgcn_global_load_lds((const unsigned*)((const char*)(gbase) + (voff)[_i]), (LAS unsigned*)(lds + (bufoff) + ldsw + _i * 8192), 16, 0, 0); } while (0)
#define PG8_LDA(dst, b, h) do { _Pragma("unroll") for (int m = 0; m < 4; ++m) _Pragma("unroll") for (int k = 0; k < 2; ++k) dst[m][k] = *(const LAS bf16x8*)(lds + PG8_SA(b, h) + aoff + m * 2048 + k * 1024); } while (0)
#define PG8_LDB(dst, b, h) do { _Pragma("unroll") for (int n = 0; n < 2; ++n) _Pragma("unroll") for (int k = 0; k < 2; ++k) dst[n][k] = *(const LAS bf16x8*)(lds + PG8_SB(b, h) + boff + n * 2048 + k * 1024); } while (0)
#define PG8_MMA(ai, bj, At, Bt) do { __builtin_amdgcn_s_setprio(1); _Pragma("unroll") for (int m = 0; m < 4; ++m) _Pragma("unroll") for (int n = 0; n < 2; ++n) _Pragma("unroll") for (int k = 0; k < 2; ++k) \
        acc[ai][bj][m][n] = __builtin_amdgcn_mfma_f32_16x16x32_bf16(Bt[n][k], At[m][k], acc[ai][bj][m][n], 0, 0, 0); __builtin_amdgcn_s_setprio(0); } while (0)
#define PG8_WAIT_V(n) asm volatile("s_waitcnt vmcnt(" #n ")" ::: "memory")
#define PG8_WAIT_L(n) asm volatile("s_waitcnt lgkmcnt(" #n ")" ::: "memory")
#define PG8_BAR __builtin_amdgcn_s_barrier()
#define PG8_SCHED __builtin_amdgcn_sched_barrier(0)
    Unit cur, nxt; int ui = 0;
    if (!S.next(0, cur)) return;
    f32x4 acc[2][2][4][2];
#pragma unroll
    for (int a = 0; a < 2; ++a)
#pragma unroll
        for (int b = 0; b < 2; ++b)
#pragma unroll
            for (int m = 0; m < 4; ++m)
#pragma unroll
                for (int n = 0; n < 2; ++n) acc[a][b][m][n] = (f32x4){0.f, 0.f, 0.f, 0.f};
    bf16x8 At[4][2], Bf0[2][2], Bf1[2][2];
    const int ntq = nt / S.nsplit;
    const char* cA = (const char*)(cur.gid ? A1 : A0) + (size_t)cur.pm * tstep + (cur.ks > 0 ? (size_t)cur.ks * ntq * kstep : 0); const char* cB = (const char*)(cur.gid ? B1 : B0) + (size_t)cur.pn * tstep + (cur.ks > 0 ? (size_t)cur.ks * ntq * kstep : 0);
    PG8_STAGE(PG8_SB(0, 0), cB, voffB); PG8_STAGE(PG8_SB(0, 1), cB + hstep, voffB); PG8_STAGE(PG8_SA(0, 0), cA, voffA); PG8_STAGE(PG8_SA(0, 1), cA + hstep, voffA);
    if (wr == 1) PG8_BAR;
    PG8_WAIT_V(2); PG8_BAR;
    PG8_STAGE(PG8_SB(1, 0), cB + kstep, voffB); PG8_STAGE(PG8_SA(1, 0), cA + kstep, voffA); PG8_STAGE(PG8_SB(1, 1), cB + hstep + kstep, voffB);
    PG8_WAIT_V(6); PG8_BAR;
    for (;;) {
        const bool has_next = S.next(ui + 1, nxt);
        const size_t nko = (has_next && nxt.ks > 0) ? (size_t)nxt.ks * ntq * kstep : 0;
        const char* nA = has_next ? (const char*)(nxt.gid ? A1 : A0) + (size_t)nxt.pm * tstep + nko : cA; const char* nB = has_next ? (const char*)(nxt.gid ? B1 : B0) + (size_t)nxt.pn * tstep + nko : cB;
        const int cnt = cur.ks < 0 ? nt : ntq;
        for (int t = 0; t < cnt; t += 2) {
            const bool last = (t == cnt - 2);
            const char* a1 = cA + (size_t)(t + 1) * kstep;
            const char* a2 = last ? nA : cA + (size_t)(t + 2) * kstep; const char* b2 = last ? nB : cB + (size_t)(t + 2) * kstep;
            const char* a3 = a2 + kstep; const char* b3 = b2 + kstep;
            PG8_LDB(Bf0, 0, 0); PG8_LDB(Bf1, 0, 1); PG8_SCHED; PG8_LDA(At, 0, 0); PG8_STAGE(PG8_SA(1, 1), a1 + hstep, voffA);
            PG8_WAIT_V(8); PG8_WAIT_L(0); PG8_BAR; PG8_MMA(0, 0, At, Bf0); PG8_MMA(0, 1, At, Bf1); PG8_BAR; PG8_SCHED;
            PG8_LDA(At, 0, 1); PG8_STAGE(PG8_SB(0, 0), b2, voffB); PG8_STAGE(PG8_SB(0, 1), b2 + hstep, voffB); PG8_STAGE(PG8_SA(0, 0), a2, voffA);
            PG8_WAIT_V(8); PG8_WAIT_L(0); PG8_BAR; PG8_MMA(1, 0, At, Bf0); PG8_MMA(1, 1, At, Bf1); PG8_BAR; PG8_SCHED;
            PG8_LDB(Bf0, 1, 0); PG8_LDB(Bf1, 1, 1); PG8_SCHED; PG8_LDA(At, 1, 0); PG8_STAGE(PG8_SA(0, 1), a2 + hstep, voffA);
            PG8_WAIT_V(8); PG8_WAIT_L(0); PG8_BAR; PG8_MMA(0, 0, At, Bf0); PG8_MMA(0, 1, At, Bf1); PG8_BAR; PG8_SCHED;
            PG8_LDA(At, 1, 1); PG8_STAGE(PG8_SB(1, 0), b3, voffB); PG8_STAGE(PG8_SB(1, 1), b3 + hstep, voffB); PG8_STAGE(PG8_SA(1, 0), a3, voffA);
            PG8_WAIT_V(8); PG8_WAIT_L(0); PG8_BAR; PG8_MMA(1, 0, At, Bf0); PG8_MMA(1, 1, At, Bf1); PG8_BAR; PG8_SCHED;
        }
        if (wr == 0) PG8_BAR;
        PG8_WAIT_V(0);
        E(acc, cur, wr, wc, fr, fq);
        if (!has_next) break;
#pragma unroll
        for (int a = 0; a < 2; ++a)
#pragma unroll
            for (int b = 0; b < 2; ++b)
#pragma unroll
                for (int m = 0; m < 4; ++m)
#pragma unroll
                    for (int n = 0; n < 2; ++n) acc[a][b][m][n] = (f32x4){0.f, 0.f, 0.f, 0.f};
        cur = nxt; cA = nA; cB = nB; ++ui;
        if (wr == 1) PG8_BAR;
    }
    PG8_WAIT_V(0);
    PG8_BAR;
#undef PG8_SA
#undef PG8_SB
#undef PG8_STAGE
#undef PG8_LDA
#undef PG8_LDB
#undef PG8_MMA
#undef PG8_WAIT_V
#undef PG8_WAIT_L
#undef PG8_BAR
#undef PG8_SCHED
}

#define FOR_AI_M _Pragma("unroll") for (int ai = 0; ai < 2; ++ai) _Pragma("unroll") for (int m = 0; m < 4; ++m)
#define FOR_BJ _Pragma("unroll") for (int bj = 0; bj < 2; ++bj)

struct EpiP1 {
    static constexpr bool MIDK = false;
    LAS float* X;
    bf16_t *QB, *KA, *VA, *BB, *CB, *UB, *MK, *MV;
    float *pk, *pv, *sk, *sv, *pmk, *pmv;
    const float *gq, *gk, *gxk; float c2;
    __device__ __forceinline__ void operator()(f32x4 (&acc)[2][2][4][2], const Unit& u, int wr, int wc, int fr, int fq) const {
        int hw = 0, kind = 0; const float* gain = nullptr; float sc = 1.f; bf16_t* ob; float* fp = nullptr; float* fs = nullptr;
        const int cb = (u.pn & 3) * 256;
        if (u.gid == 0) { const int seg = u.pn >> 2;
            if (seg == 0) { hw = 128; gain = gq; sc = c2; ob = QB; }
            else if (seg == 1) { hw = 128; gain = gk; ob = KA; fp = pk; fs = sk; kind = 1; }
            else if (seg == 2) { ob = VA; fp = pv; fs = sv; kind = 1; }
            else if (seg == 3) ob = BB; else { ob = CB; kind = 3; }
        } else { kind = 2; if (u.pn < 4) { hw = 256; gain = gxk; ob = MK; fp = pmk; } else { ob = MV; fp = pmv; } }
        float tot[2][4][2];
        if (hw) head_ss(acc, tot, X, wr, wc, fr, fq);
        f32x4 gv[2][2];
        FOR_BJ
#pragma unroll
            for (int n = 0; n < 2; ++n) gv[bj][n] = gain ? *(const f32x4*)(gain + (hw == 256 ? 128 * bj : 0) + 32 * wc + 8 * fq + 4 * n) : (f32x4){1.f, 1.f, 1.f, 1.f};
        FOR_AI_M {
            const int grow = u.pm * BM + ai * HALF + wr * 64 + m * 16 + fr;
            size_t brow = (size_t)grow; long frow = -1; float* fb = nullptr;
            if (kind == 2) { frow = grow; fb = fp; }
            else if (kind == 1) {
                if (grow < NPR) { const int t = grow & (SEQ - 1); if (t >= SEQ - 512) { frow = (long)(grow >> 13) * 512 + t - (SEQ - 512); fb = fp; } }
                else { const int s = grow - NPR, b = s >> 6, t = s & 63; brow = (size_t)NPR + (size_t)b * 576 + 512 + t; frow = (long)b * 512 + 448 + t; fb = fs; }
            }
            FOR_BJ {
                float sl = 1.f;
                if (hw) { const float t = (hw == 128) ? tot[ai][m][bj] : tot[ai][m][0] + tot[ai][m][1]; sl = rsqrtf(t / (float)hw + EPS) * sc; }
                const f32x4 v0 = acc[ai][bj][m][0] * sl * gv[bj][0], v1 = acc[ai][bj][m][1] * sl * gv[bj][1];
                const int col = cb + 128 * bj + 32 * wc + 8 * fq;
                if (kind == 3) {
                    if (bj == 0) *(u32x4*)(CB + brow * 1024 + (u.pn - 16) * 128 + 32 * wc + 8 * fq) = pack8(acc[ai][0][m][0] * acc[ai][1][m][0], acc[ai][0][m][1] * acc[ai][1][m][1]);
                    continue; }
                *(u32x4*)(ob + brow * 1024 + col) = pack8(v0, v1);
                if (fb) { *(f32x4*)(fb + (size_t)frow * 1024 + col) = v0; *(f32x4*)(fb + (size_t)frow * 1024 + col + 4) = v1; }
            }
            asm volatile("" ::: "memory");
        }
    }
};

struct EpiP3 {
    static constexpr bool MIDK = false;
    LAS float* X; const float *xp, *xs; bf16_t* HB; float* SS2;
    __device__ __forceinline__ void operator()(f32x4 (&acc)[2][2][4][2], const Unit& u, int wr, int wc, int fr, int fq) const {
        const float* xb = u.pm < NPR / BM ? xp : xs - (size_t)NPR * DM;
#pragma unroll
        for (int ai = 0; ai < 2; ++ai) {
            f32x4 xr[4][2][2];
#pragma unroll
            for (int m = 0; m < 4; ++m) FOR_BJ { const unsigned off = (unsigned)(u.pm * BM + ai * HALF + wr * 64 + m * 16 + fr) * DM + u.pn * BM + 128 * bj + 32 * wc + 8 * fq;
                xr[m][bj][0] = *(const f32x4*)(xb + off); xr[m][bj][1] = *(const f32x4*)(xb + off + 4); }
#pragma unroll
            for (int m = 0; m < 4; ++m) FOR_BJ { const unsigned off = (unsigned)(u.pm * BM + ai * HALF + wr * 64 + m * 16 + fr) * DM + u.pn * BM + 128 * bj + 32 * wc + 8 * fq;
                const f32x4 v0 = acc[ai][bj][m][0] + xr[m][bj][0], v1 = acc[ai][bj][m][1] + xr[m][bj][1];
                acc[ai][bj][m][0] = v0; acc[ai][bj][m][1] = v1;
                *(u32x4*)(HB + off) = pack8(v0, v1); }
            asm volatile("" ::: "memory");
        }
        float tot[2][4][2]; head_ss(acc, tot, X, wr, wc, fr, fq);
        if (wc == 0 && fq == 0) { FOR_AI_M { const int grow = u.pm * BM + ai * HALF + wr * 64 + m * 16 + fr; SS2[(size_t)grow * 8 + u.pn] = tot[ai][m][0] + tot[ai][m][1]; } }
    }
};

struct EpiP4 {
    static constexpr bool MIDK = false;
    LAS float* X; const float* SS2; const float* gxq; bf16_t* QX; float c2x;
    __device__ __forceinline__ void operator()(f32x4 (&acc)[2][2][4][2], const Unit& u, int wr, int wc, int fr, int fq) const {
        FOR_AI_M { const int grow = u.pm * BM + ai * HALF + wr * 64 + m * 16 + fr;
            const f32x4 a0 = *(const f32x4*)(SS2 + (size_t)grow * 8), a1 = *(const f32x4*)(SS2 + (size_t)grow * 8 + 4);
            const float r2 = rsqrtf(((a0[0] + a0[1]) + (a0[2] + a0[3]) + (a1[0] + a1[1]) + (a1[2] + a1[3])) * (1.f / 2048.f) + EPS);
            FOR_BJ { acc[ai][bj][m][0] *= r2; acc[ai][bj][m][1] *= r2; } }
        float tot[2][4][2]; head_ss(acc, tot, X, wr, wc, fr, fq);
        f32x4 gv[2][2];
        FOR_BJ
#pragma unroll
            for (int n = 0; n < 2; ++n) gv[bj][n] = *(const f32x4*)(gxq + 128 * bj + 32 * wc + 8 * fq + 4 * n);
        FOR_AI_M { const int grow = u.pm * BM + ai * HALF + wr * 64 + m * 16 + fr;
            const float s = rsqrtf((tot[ai][m][0] + tot[ai][m][1]) * (1.f / 256.f) + EPS) * c2x;
            FOR_BJ { const int col = u.pn * BM + 128 * bj + 32 * wc + 8 * fq;
                *(u32x4*)(QX + (size_t)grow * 1024 + col) = pack8(acc[ai][bj][m][0] * s * gv[bj][0], acc[ai][bj][m][1] * s * gv[bj][1]); } }
    }
};

struct EpiP6 {
    static constexpr bool MIDK = false;
    LAS float* X; bf16_t* H2B; float* SS3;
    __device__ __forceinline__ void operator()(f32x4 (&acc)[2][2][4][2], const Unit& u, int wr, int wc, int fr, int fq) const {
#pragma unroll
        for (int ai = 0; ai < 2; ++ai) {
            u32x4 hr[4][2];
#pragma unroll
            for (int m = 0; m < 4; ++m) FOR_BJ { const unsigned off = (unsigned)(u.pm * BM + ai * HALF + wr * 64 + m * 16 + fr) * DM + u.pn * BM + 128 * bj + 32 * wc + 8 * fq; hr[m][bj] = *(const u32x4*)(H2B + off); }
#pragma unroll
            for (int m = 0; m < 4; ++m) FOR_BJ { const unsigned off = (unsigned)(u.pm * BM + ai * HALF + wr * 64 + m * 16 + fr) * DM + u.pn * BM + 128 * bj + 32 * wc + 8 * fq;
                const u32x4 h = hr[m][bj];
                const f32x4 v0 = acc[ai][bj][m][0] + (f32x4){bflo(h.x), bfhi(h.x), bflo(h.y), bfhi(h.y)}, v1 = acc[ai][bj][m][1] + (f32x4){bflo(h.z), bfhi(h.z), bflo(h.w), bfhi(h.w)};
                acc[ai][bj][m][0] = v0; acc[ai][bj][m][1] = v1;
                *(u32x4*)(H2B + off) = pack8(v0, v1); }
            asm volatile("" ::: "memory");
        }
        float tot[2][4][2]; head_ss(acc, tot, X, wr, wc, fr, fq);
        if (wc == 0 && fq == 0) { FOR_AI_M { const int grow = u.pm * BM + ai * HALF + wr * 64 + m * 16 + fr; SS3[(size_t)grow * 8 + u.pn] = tot[ai][m][0] + tot[ai][m][1]; } }
    }
};

__device__ __forceinline__ float dpp_ror1(float v) { return __builtin_bit_cast(float, __builtin_amdgcn_update_dpp(0, __builtin_bit_cast(int, v), 0x121, 0xf, 0xf, false)); }
__device__ __forceinline__ float dpp_ror2(float v) { return __builtin_bit_cast(float, __builtin_amdgcn_update_dpp(0, __builtin_bit_cast(int, v), 0x122, 0xf, 0xf, false)); }
__device__ __forceinline__ float silu_mul(float cv, float g) { return cv * __builtin_amdgcn_rcpf(1.f + __builtin_amdgcn_exp2f(-cv * LOG2E)) * g; }
struct EpiP7 {
    static constexpr bool MIDK = false;
    LAS float* XH; const float* SS3; bf16_t* ACT; float *pf, *sf; const float* cffn; const float* wf; float *TAIL, *HEADU, *HEADG;
    __device__ __forceinline__ void operator()(f32x4 (&acc)[2][2][4][2], const Unit& u, int wr, int wc, int fr, int fq) const {
        const int f0 = u.pn * 128 + 32 * wc + 8 * fq;
        const bool smp = u.pm >= NPR / BM;
        FOR_AI_M { const int grow = u.pm * BM + ai * HALF + wr * 64 + m * 16 + fr;
            const f32x4 a0 = *(const f32x4*)(SS3 + (size_t)grow * 8), a1 = *(const f32x4*)(SS3 + (size_t)grow * 8 + 4);
            const float r3 = rsqrtf(((a0[0] + a0[1]) + (a0[2] + a0[3]) + (a1[0] + a1[1]) + (a1[2] + a1[3])) * (1.f / 2048.f) + EPS);
            FOR_BJ { acc[ai][bj][m][0] *= r3; acc[ai][bj][m][1] *= r3; } }
        if (fr >= 14) {
#pragma unroll
            for (int ai = 0; ai < 2; ++ai) { LAS float* xp = XH + ((2 * ai + wr) * 2 + (fr - 14)) * 128 + 32 * wc + 8 * fq; *(LAS f32x4*)xp = acc[ai][0][3][0]; *(LAS f32x4*)(xp + 4) = acc[ai][0][3][1]; } }
        EPI_BAR();
        FOR_AI_M { const int grow = u.pm * BM + ai * HALF + wr * 64 + m * 16 + fr;
            float* fo = nullptr;
            if (!smp) { const int t = grow & (SEQ - 1); if (t >= SEQ - 2) fo = pf + ((size_t)(grow >> 13) * 2 + (t - (SEQ - 2))) * DFF; }
            else { const int s = grow - NPR, t = s & 63; if (t >= 62) fo = sf + ((size_t)(s >> 6) * 2 + (t - 62)) * DFF; }
            if (fo) { *(f32x4*)(fo + f0) = acc[ai][0][m][0]; *(f32x4*)(fo + f0 + 4) = acc[ai][0][m][1]; } }
        if (!smp) {
            if (wr == 1 && fr >= 14) { float* tp = TAIL + ((size_t)u.pm * 2 + (fr - 14)) * DFF + f0; *(f32x4*)tp = acc[1][0][3][0]; *(f32x4*)(tp + 4) = acc[1][0][3][1]; }
            if (wr == 0 && fr < 2) { float* hp = HEADU + ((size_t)u.pm * 2 + fr) * DFF + f0; *(f32x4*)hp = acc[0][0][0][0]; *(f32x4*)(hp + 4) = acc[0][0][0][1];
                                     float* gp = HEADG + ((size_t)u.pm * 2 + fr) * DFF + f0; *(f32x4*)gp = acc[0][1][0][0]; *(f32x4*)(gp + 4) = acc[0][1][0][1]; }
        }
        f32x4 w0[2], w1[2], w2[2];
#pragma unroll
        for (int n = 0; n < 2; ++n) { w0[n] = *(const f32x4*)(wf + f0 + 4 * n); w1[n] = *(const f32x4*)(wf + DFF + f0 + 4 * n); w2[n] = *(const f32x4*)(wf + 2 * DFF + f0 + 4 * n); }
#pragma unroll
        for (int ai = 0; ai < 2; ++ai) {
            const int blk = 2 * ai + wr;
            f32x4 pv[2];
            if (smp) { const int b = (u.pm * BM - NPR) / 64 + blk; const float* cp = cffn + ((size_t)b * 2 + (fr == 15 ? 1 : 0)) * DFF + f0; pv[0] = *(const f32x4*)cp; pv[1] = *(const f32x4*)(cp + 4); }
            else if (blk == 0) { pv[0] = (f32x4){0.f, 0.f, 0.f, 0.f}; pv[1] = pv[0]; }
            else { const LAS float* xp = XH + ((blk - 1) * 2 + (fr == 15 ? 1 : 0)) * 128 + 32 * wc + 8 * fq; pv[0] = *(const LAS f32x4*)xp; pv[1] = *(const LAS f32x4*)(xp + 4); }
#pragma unroll
            for (int m = 0; m < 4; ++m) {
                const int grow = u.pm * BM + ai * HALF + wr * 64 + m * 16 + fr;
                f32x4 av[2];
#pragma unroll
                for (int n = 0; n < 2; ++n)
#pragma unroll
                    for (int e = 0; e < 4; ++e) {
                        const float cur = acc[ai][0][m][n][e], prv = pv[n][e];
                        const float a1 = dpp_ror1(cur), b1 = dpp_ror1(prv), a2 = dpp_ror2(cur), b2 = dpp_ror2(prv);
                        const float p1 = fr >= 1 ? a1 : b1, p2 = fr >= 2 ? a2 : b2;
                        const float cv = w0[n][e] * p2 + w1[n][e] * p1 + w2[n][e] * cur;
                        av[n][e] = silu_mul(cv, acc[ai][1][m][n][e]);
                    }
                *(u32x4*)(ACT + (size_t)grow * DFF + f0) = pack8(av[0], av[1]);
                pv[0] = acc[ai][0][m][0]; pv[1] = acc[ai][0][m][1];
            }
        }
    }
};

struct EpiP9 {
    static constexpr bool MIDK = false;
    float* Y; const bf16_t* H2B; float* PART;
    __device__ __forceinline__ void operator()(f32x4 (&acc)[2][2][4][2], const Unit& u, int wr, int wc, int fr, int fq) const {
        if (u.ks >= 0) {
            float* pp = PART + (size_t)(u.tail * 4 + u.ks) * 65536;
            FOR_AI_M FOR_BJ { float* yp = pp + (ai * HALF + wr * 64 + m * 16 + fr) * 256 + 128 * bj + 32 * wc + 8 * fq; *(f32x4*)yp = acc[ai][bj][m][0]; *(f32x4*)(yp + 4) = acc[ai][bj][m][1]; }
            return;
        }
#pragma unroll
        for (int ai = 0; ai < 2; ++ai) {
            u32x4 hr[4][2];
#pragma unroll
            for (int m = 0; m < 4; ++m) FOR_BJ { const unsigned off = (unsigned)(u.pm * BM + ai * HALF + wr * 64 + m * 16 + fr) * DM + u.pn * BM + 128 * bj + 32 * wc + 8 * fq; hr[m][bj] = *(const u32x4*)(H2B + off); }
#pragma unroll
            for (int m = 0; m < 4; ++m) FOR_BJ { const unsigned off = (unsigned)(u.pm * BM + ai * HALF + wr * 64 + m * 16 + fr) * DM + u.pn * BM + 128 * bj + 32 * wc + 8 * fq;
                const u32x4 h = hr[m][bj];
                *(f32x4*)(Y + off) = acc[ai][bj][m][0] + (f32x4){bflo(h.x), bfhi(h.x), bflo(h.y), bfhi(h.y)};
                *(f32x4*)(Y + off + 4) = acc[ai][bj][m][1] + (f32x4){bflo(h.z), bfhi(h.z), bflo(h.w), bfhi(h.w)}; }
            asm volatile("" ::: "memory");
        }
    }
};

#define VTR8(r, A0, A1, A2, A3) asm volatile( \
    "ds_read_b64_tr_b16 %0, %8\n\tds_read_b64_tr_b16 %1, %9\n\tds_read_b64_tr_b16 %2, %8 offset:4096\n\tds_read_b64_tr_b16 %3, %9 offset:4096\n\t" \
    "ds_read_b64_tr_b16 %4, %10\n\tds_read_b64_tr_b16 %5, %11\n\tds_read_b64_tr_b16 %6, %10 offset:4096\n\tds_read_b64_tr_b16 %7, %11 offset:4096" \
    : "=&v"(r[0]), "=&v"(r[1]), "=&v"(r[2]), "=&v"(r[3]), "=&v"(r[4]), "=&v"(r[5]), "=&v"(r[6]), "=&v"(r[7]) : "v"(A0), "v"(A1), "v"(A2), "v"(A3) : "memory")
#define VTRW(n, r, x, y) asm volatile("s_waitcnt lgkmcnt(" #n ")" : "+v"(r[0]), "+v"(r[1]), "+v"(r[2]), "+v"(r[3]), "+v"(r[4]), "+v"(r[5]), "+v"(r[6]), "+v"(r[7]), "+v"(x), "+v"(y) :: "memory")
#define VFR2(lo, hi2) ((bf16x8){lo[0], lo[1], lo[2], lo[3], hi2[0], hi2[1], hi2[2], hi2[3]})
__device__ __forceinline__ s16x4 vtr(const LAS unsigned char* p) { typedef short v4i16 __attribute__((ext_vector_type(4))); return __builtin_bit_cast(s16x4, __builtin_amdgcn_ds_read_tr16_b64_v4i16((LAS v4i16*)p)); }

template <int NKI, int NS, bool BAND>
__device__ __forceinline__ void attn_unit(LAS unsigned char* lds, const bf16_t* Kg, const bf16_t* Vg, const int colbase, const int nsteps, const bf16_t* Qg, const int nq,
                                          bf16_t* Og, const int ldo, float* ssa, const int head0, const int crel0, const LAS float* btab, const float cinit) {
    const int tid = threadIdx.x, lane = tid & 63, w = __builtin_amdgcn_readfirstlane(tid >> 6), hi = lane >> 5, l31 = lane & 31;
    constexpr int TILE = 8192, NT = NS * 2 * NKI, STG = NT * TILE;
    const int s = BAND ? (w >> 1) : 0, qb = BAND ? (w & 1) : (w >> 1), dsel = BAND ? 0 : (w & 1);
    const int col0 = colbase + s * 128 * NKI;
    const bool active = qb * 32 < nq;
    const int drow = 4 * w + (lane >> 4), fdr = ((drow & 3) << 2) | ((drow >> 2) & 3);
    const size_t goff = (size_t)drow * 2048 + (size_t)(((lane & 15) ^ fdr) << 4);
#define ATT_ISSUE(j_, stg_) do { const char* kb_ = (const char*)Kg + (size_t)(j_) * 65536 + goff; const char* vb_ = (const char*)Vg + (size_t)(j_) * 65536 + goff; \
        LAS unsigned char* d_ = lds + (stg_) * STG + w * 1024; \
        _Pragma("unroll") for (int s_ = 0; s_ < NS; ++s_) _Pragma("unroll") for (int i_ = 0; i_ < NKI; ++i_) { \
            const int cc_ = (colbase + s_ * 128 * NKI + i_ * 128) * 2; \
            __builtin_amdgcn_global_load_lds((const unsigned*)(kb_ + cc_), (LAS unsigned*)(d_ + (s_ * 2 * NKI + i_) * TILE), 16, 0, 0); \
            __builtin_amdgcn_global_load_lds((const unsigned*)(vb_ + cc_), (LAS unsigned*)(d_ + (s_ * 2 * NKI + NKI + i_) * TILE), 16, 0, 0); } } while (0)
    ATT_ISSUE(0, 0);
    bf16x8 qf[8 * NKI];
    if (active) { const bf16_t* qp = Qg + (size_t)(qb * 32 + l31) * 1024 + col0 + 8 * hi;
#pragma unroll
        for (int i = 0; i < 8 * NKI; ++i) qf[i] = *(const bf16x8*)(qp + 16 * i); }
    else {
#pragma unroll
        for (int i = 0; i < 8 * NKI; ++i) qf[i] = (bf16x8){0, 0, 0, 0, 0, 0, 0, 0}; }
    const int fl = ((l31 & 3) << 2) | ((l31 >> 2) & 3);
    int koff[8];
#pragma unroll
    for (int s8 = 0; s8 < 8; ++s8) koff[s8] = 256 * l31 + (((2 * s8 + hi) ^ fl) << 4);
    const int q4 = (lane & 15) >> 2, blk = (lane >> 4) & 1, p4 = lane & 3;
    int voff[2][4];
#pragma unroll
    for (int t = 0; t < 2; ++t)
#pragma unroll
        for (int c = 0; c < 4; ++c) voff[t][c] = 256 * (4 * hi + 8 * t + q4) + ((((c ^ q4) << 2) | ((2 * blk + (p4 >> 1)) ^ ((hi + 2 * t) & 3))) << 4) + 8 * (p4 & 1);
    f32x16 o[4];
#pragma unroll
    for (int c = 0; c < 4; ++c)
#pragma unroll
        for (int r = 0; r < 16; ++r) o[c][r] = 0.f;
    float lsum = 0.f;
    const LAS float* tb = btab + (head0 + s) * 264;
    const float cfar = BAND ? tb[256] : cinit;
    asm volatile("s_waitcnt vmcnt(0) lgkmcnt(0)" ::: "memory"); __builtin_amdgcn_s_barrier(); asm volatile("" ::: "memory");
    for (int j = 0; j < nsteps; ++j) {
        if (j + 1 < nsteps) ATT_ISSUE(j + 1, (j + 1) & 1);
        if (active) {
            const LAS unsigned char* st = lds + (j & 1) * STG;
            const LAS unsigned char* Kt = st + (s * 2 * NKI) * TILE; const LAS unsigned char* Vt = st + (s * 2 * NKI + NKI + dsel) * TILE;
            f32x16 sc;
            bool nearb = false;
            if (BAND) { const int kcrel = crel0 - (j >> 1); nearb = kcrel < 3;
                if (nearb) { const int dbase = 64 * kcrel - 32 * (j & 1) + qb * 32 + l31 - 4 * hi;
#pragma unroll
                    for (int r = 0; r < 16; ++r) { int d = dbase - ((r & 3) + 8 * (r >> 2)); d = d > 128 ? 128 : d; sc[r] = tb[d + 128]; } } }
            if (!nearb) {
#pragma unroll
                for (int r = 0; r < 16; ++r) sc[r] = cfar; }
#pragma unroll
            for (int i = 0; i < NKI; ++i) {
                bf16x8 kf[8];
#pragma unroll
                for (int s8 = 0; s8 < 8; ++s8) kf[s8] = *(const LAS bf16x8*)(Kt + i * TILE + koff[s8]);
                asm volatile("s_waitcnt lgkmcnt(0)" : "+v"(kf[0]), "+v"(kf[1]), "+v"(kf[2]), "+v"(kf[3]), "+v"(kf[4]), "+v"(kf[5]), "+v"(kf[6]), "+v"(kf[7]) :: "memory");
#pragma unroll
                for (int s8 = 0; s8 < 8; ++s8) sc = __builtin_amdgcn_mfma_f32_32x32x16_bf16(kf[s8], qf[i * 8 + s8], sc, 0, 0, 0);
            }
            s16x4 va[8], vb[8];
            { const unsigned sb = (unsigned)(size_t)Vt; VTR8(va, sb + voff[0][0], sb + voff[1][0], sb + voff[0][1], sb + voff[1][1]); VTR8(vb, sb + voff[0][2], sb + voff[1][2], sb + voff[0][3], sb + voff[1][3]); }
            float pe[16];
#pragma unroll
            for (int r = 0; r < 16; ++r) { pe[r] = __builtin_amdgcn_exp2f(sc[r]); lsum += pe[r]; }
            u32x4 pw0, pw1;
            pw0.x = cvtpk(pe[0], pe[1]); pw0.y = cvtpk(pe[2], pe[3]); pw0.z = cvtpk(pe[4], pe[5]); pw0.w = cvtpk(pe[6], pe[7]);
            pw1.x = cvtpk(pe[8], pe[9]); pw1.y = cvtpk(pe[10], pe[11]); pw1.z = cvtpk(pe[12], pe[13]); pw1.w = cvtpk(pe[14], pe[15]);
            VTRW(8, va, pw0, pw1);
            const bf16x8 pa0 = __builtin_bit_cast(bf16x8, pw0), pa1 = __builtin_bit_cast(bf16x8, pw1);
            o[0] = __builtin_amdgcn_mfma_f32_32x32x16_bf16(pa0, VFR2(va[0], va[1]), o[0], 0, 0, 0); o[0] = __builtin_amdgcn_mfma_f32_32x32x16_bf16(pa1, VFR2(va[2], va[3]), o[0], 0, 0, 0);
            o[1] = __builtin_amdgcn_mfma_f32_32x32x16_bf16(pa0, VFR2(va[4], va[5]), o[1], 0, 0, 0); o[1] = __builtin_amdgcn_mfma_f32_32x32x16_bf16(pa1, VFR2(va[6], va[7]), o[1], 0, 0, 0);
            VTRW(0, vb, pw0, pw1);
            o[2] = __builtin_amdgcn_mfma_f32_32x32x16_bf16(pa0, VFR2(vb[0], vb[1]), o[2], 0, 0, 0); o[2] = __builtin_amdgcn_mfma_f32_32x32x16_bf16(pa1, VFR2(vb[2], vb[3]), o[2], 0, 0, 0);
            o[3] = __builtin_amdgcn_mfma_f32_32x32x16_bf16(pa0, VFR2(vb[4], vb[5]), o[3], 0, 0, 0); o[3] = __builtin_amdgcn_mfma_f32_32x32x16_bf16(pa1, VFR2(vb[6], vb[7]), o[3], 0, 0, 0);
        }
        asm volatile("s_waitcnt vmcnt(0) lgkmcnt(0)" ::: "memory"); __builtin_amdgcn_s_barrier(); asm volatile("" ::: "memory");
    }
#undef ATT_ISSUE
    LAS unsigned char* stg = lds + w * 8704;
    LAS float* lsc = (LAS float*)(lds + LSC_OFF) + w * 32;
    if (active) {
        const float l = lsum + __shfl_xor(lsum, 32);
        if (hi == 0) lsc[l31] = l;
        asm volatile("s_waitcnt lgkmcnt(0)" ::: "memory");
#pragma unroll
        for (int r = 0; r < 16; ++r) { const int q = (r & 3) + 8 * (r >> 2) + 4 * hi; const float rl = 1.f / lsc[q];
#pragma unroll
            for (int c = 0; c < 4; ++c) *(LAS bf16_t*)(stg + q * 272 + (32 * c + l31) * 2) = (bf16_t)f2bf(o[c][r] * rl); }
        asm volatile("s_waitcnt lgkmcnt(0)" ::: "memory");
        const int row = lane >> 1, half = lane & 1;
        bf16_t* op = Og + (size_t)(qb * 32 + row) * ldo + col0 + dsel * 128 + half * 64;
        float ss = 0.f;
#pragma unroll
        for (int i = 0; i < 8; ++i) { const u32x4 v = *(const LAS u32x4*)(stg + row * 272 + half * 128 + i * 16);
            ss += bflo(v.x) * bflo(v.x) + bfhi(v.x) * bfhi(v.x) + bflo(v.y) * bflo(v.y) + bfhi(v.y) * bfhi(v.y) + bflo(v.z) * bflo(v.z) + bfhi(v.z) * bfhi(v.z) + bflo(v.w) * bflo(v.w) + bfhi(v.w) * bfhi(v.w);
            *(u32x4*)(op + i * 8) = v; }
        if (BAND) { ss += __shfl_xor(ss, 1); if (half == 0) ssa[(size_t)(qb * 32 + row) * 8 + head0 + s] = ss; }
    }
    asm volatile("s_waitcnt lgkmcnt(0)" ::: "memory"); __builtin_amdgcn_s_barrier(); asm volatile("" ::: "memory");
}

template <int D>
__device__ __forceinline__ void band_unit(LAS unsigned char* lds, const bf16_t* Kg, const bf16_t* Vg, const int ntile, const bf16_t* Qg, bf16_t* Og, float* ssa, const int nci, const int crel0, const LAS float* tb) {
    const int tid = threadIdx.x, lane = tid & 63, w = __builtin_amdgcn_readfirstlane(tid >> 6), hi = lane >> 5, l31 = lane & 31;
    constexpr int STG = 16384;
    const int ci = w >> 1, qb = w & 1;
    const bool wact = ci < nci;
    const int drow = 4 * w + (lane >> 4), fdr = ((drow & 3) << 2) | ((drow >> 2) & 3);
    const size_t goff = (size_t)drow * 2048 + (size_t)(((lane & 15) ^ fdr) << 4);
#define BISSUE(j_) do { LAS unsigned char* d_ = lds + ((j_) & (D - 1)) * STG + w * 1024; \
        __builtin_amdgcn_global_load_lds((const unsigned*)((const char*)Kg + (size_t)(j_) * 65536 + goff), (LAS unsigned*)d_, 16, 0, 0); \
        __builtin_amdgcn_global_load_lds((const unsigned*)((const char*)Vg + (size_t)(j_) * 65536 + goff), (LAS unsigned*)(d_ + 8192), 16, 0, 0); } while (0)
    bf16x8 qf[8];
    if (wact) { const bf16_t* qp = Qg + (size_t)(64 * ci + 32 * qb + l31) * 1024 + 8 * hi;
#pragma unroll
        for (int i = 0; i < 8; ++i) qf[i] = *(const bf16x8*)(qp + 16 * i); }
    else {
#pragma unroll
        for (int i = 0; i < 8; ++i) qf[i] = (bf16x8){0, 0, 0, 0, 0, 0, 0, 0}; }
#pragma unroll
    for (int j = 0; j < 4; ++j) if (j < ntile) BISSUE(j);
    const int fl = ((l31 & 3) << 2) | ((l31 >> 2) & 3);
    int koff[8];
#pragma unroll
    for (int s8 = 0; s8 < 8; ++s8) koff[s8] = 256 * l31 + (((2 * s8 + hi) ^ fl) << 4);
    const int q4 = (lane & 15) >> 2, blk = (lane >> 4) & 1, p4 = lane & 3;
    int voff[2][4];
#pragma unroll
    for (int t = 0; t < 2; ++t)
#pragma unroll
        for (int c = 0; c < 4; ++c) voff[t][c] = 8192 + 256 * (4 * hi + 8 * t + q4) + ((((c ^ q4) << 2) | ((2 * blk + (p4 >> 1)) ^ ((hi + 2 * t) & 3))) << 4) + 8 * (p4 & 1);
    f32x16 o[4];
#pragma unroll
    for (int c = 0; c < 4; ++c)
#pragma unroll
        for (int r = 0; r < 16; ++r) o[c][r] = 0.f;
    float lsum = 0.f;
    const float cfar = tb[256];
    for (int j = 0; j < ntile; ++j) {
        if ((j & 3) == 0) {
            asm volatile("s_waitcnt vmcnt(0)" ::: "memory");
            __builtin_amdgcn_s_barrier(); asm volatile("" ::: "memory");
#pragma unroll
            for (int jj = 4; jj < 8; ++jj) if (j + jj < ntile) BISSUE(j + jj);
        }
        const int kcrel = crel0 + ci - (j >> 1);
        if (wact && kcrel >= 0 && kcrel <= 8) {
            const LAS unsigned char* st = lds + (j & (D - 1)) * STG;
            f32x16 sc;
            if (kcrel < 3) { const int dbase = 64 * kcrel - 32 * (j & 1) + qb * 32 + l31 - 4 * hi;
#pragma unroll
                for (int r = 0; r < 16; ++r) { int d = dbase - ((r & 3) + 8 * (r >> 2)); d = d > 128 ? 128 : d; sc[r] = tb[d + 128]; } }
            else {
#pragma unroll
                for (int r = 0; r < 16; ++r) sc[r] = cfar; }
            bf16x8 kf[8];
#pragma unroll
            for (int s8 = 0; s8 < 8; ++s8) kf[s8] = *(const LAS bf16x8*)(st + koff[s8]);
            asm volatile("s_waitcnt lgkmcnt(0)" : "+v"(kf[0]), "+v"(kf[1]), "+v"(kf[2]), "+v"(kf[3]), "+v"(kf[4]), "+v"(kf[5]), "+v"(kf[6]), "+v"(kf[7]) :: "memory");
            __builtin_amdgcn_s_setprio(1);
#pragma unroll
            for (int s8 = 0; s8 < 8; ++s8) sc = __builtin_amdgcn_mfma_f32_32x32x16_bf16(kf[s8], qf[s8], sc, 0, 0, 0);
            __builtin_amdgcn_s_setprio(0);
            s16x4 va[8], vb[8];
            { const unsigned sb = (unsigned)(size_t)st; VTR8(va, sb + voff[0][0], sb + voff[1][0], sb + voff[0][1], sb + voff[1][1]); VTR8(vb, sb + voff[0][2], sb + voff[1][2], sb + voff[0][3], sb + voff[1][3]); }
            float pe[16];
#pragma unroll
            for (int r = 0; r < 16; ++r) { pe[r] = __builtin_amdgcn_exp2f(sc[r]); lsum += pe[r]; }
            u32x4 pw0, pw1;
            pw0.x = cvtpk(pe[0], pe[1]); pw0.y = cvtpk(pe[2], pe[3]); pw0.z = cvtpk(pe[4], pe[5]); pw0.w = cvtpk(pe[6], pe[7]);
            pw1.x = cvtpk(pe[8], pe[9]); pw1.y = cvtpk(pe[10], pe[11]); pw1.z = cvtpk(pe[12], pe[13]); pw1.w = cvtpk(pe[14], pe[15]);
            VTRW(8, va, pw0, pw1);
            const bf16x8 pa0 = __builtin_bit_cast(bf16x8, pw0), pa1 = __builtin_bit_cast(bf16x8, pw1);
            o[0] = __builtin_amdgcn_mfma_f32_32x32x16_bf16(pa0, VFR2(va[0], va[1]), o[0], 0, 0, 0); o[0] = __builtin_amdgcn_mfma_f32_32x32x16_bf16(pa1, VFR2(va[2], va[3]), o[0], 0, 0, 0);
            o[1] = __builtin_amdgcn_mfma_f32_32x32x16_bf16(pa0, VFR2(va[4], va[5]), o[1], 0, 0, 0); o[1] = __builtin_amdgcn_mfma_f32_32x32x16_bf16(pa1, VFR2(va[6], va[7]), o[1], 0, 0, 0);
            VTRW(0, vb, pw0, pw1);
            o[2] = __builtin_amdgcn_mfma_f32_32x32x16_bf16(pa0, VFR2(vb[0], vb[1]), o[2], 0, 0, 0); o[2] = __builtin_amdgcn_mfma_f32_32x32x16_bf16(pa1, VFR2(vb[2], vb[3]), o[2], 0, 0, 0);
            o[3] = __builtin_amdgcn_mfma_f32_32x32x16_bf16(pa0, VFR2(vb[4], vb[5]), o[3], 0, 0, 0); o[3] = __builtin_amdgcn_mfma_f32_32x32x16_bf16(pa1, VFR2(vb[6], vb[7]), o[3], 0, 0, 0);
        }
    }
#undef BISSUE
    asm volatile("s_waitcnt vmcnt(0) lgkmcnt(0)" ::: "memory"); __builtin_amdgcn_s_barrier(); asm volatile("" ::: "memory");
    LAS unsigned char* stg = lds + w * 8704;
    LAS float* lsc = (LAS float*)(lds + LSC_OFF) + w * 32;
    if (wact) {
        const float l = lsum + __shfl_xor(lsum, 32);
        if (hi == 0) lsc[l31] = l;
        asm volatile("s_waitcnt lgkmcnt(0)" ::: "memory");
#pragma unroll
        for (int r = 0; r < 16; ++r) { const int q = (r & 3) + 8 * (r >> 2) + 4 * hi; const float rl = 1.f / lsc[q];
#pragma unroll
            for (int c = 0; c < 4; ++c) *(LAS bf16_t*)(stg + q * 272 + (32 * c + l31) * 2) = (bf16_t)f2bf(o[c][r] * rl); }
        asm volatile("s_waitcnt lgkmcnt(0)" ::: "memory");
        const int row = lane >> 1, half = lane & 1, orow = 64 * ci + 32 * qb + row;
        bf16_t* op = Og + (size_t)orow * DM + half * 64;
        float ss = 0.f;
#pragma unroll
        for (int i = 0; i < 8; ++i) { const u32x4 v = *(const LAS u32x4*)(stg + row * 272 + half * 128 + i * 16);
            ss += bflo(v.x) * bflo(v.x) + bfhi(v.x) * bfhi(v.x) + bflo(v.y) * bflo(v.y) + bfhi(v.y) * bfhi(v.y) + bflo(v.z) * bflo(v.z) + bfhi(v.z) * bfhi(v.z) + bflo(v.w) * bflo(v.w) + bfhi(v.w) * bfhi(v.w);
            *(u32x4*)(op + i * 8) = v; }
        ss += __shfl_xor(ss, 1); if (half == 0) ssa[(size_t)orow * 8] = ss;
    }
    asm volatile("s_waitcnt lgkmcnt(0)" ::: "memory"); __builtin_amdgcn_s_barrier(); asm volatile("" ::: "memory");
}

__device__ __forceinline__ void p0_transpose_item(const float* W, int K, int N, bf16_t* WT, int mode, const float* ga, const float* gb, int ksplit, LAS float* scr, int item, int lane) {
    const int nblk = N / 32, kb = item / nblk, nb = item % nblk, k0 = 64 * kb, n0 = 32 * nb;
    const float* g = ga ? (k0 < ksplit ? ga + k0 : gb + (k0 - ksplit)) : nullptr;
    f32x4 wv[8];
#pragma unroll
    for (int i = 0; i < 8; ++i) wv[i] = __builtin_nontemporal_load((const f32x4*)(W + (size_t)(k0 + 8 * i + (lane >> 3)) * N + n0 + 4 * (lane & 7)));
#pragma unroll
    for (int i = 0; i < 8; ++i) { const int kk = 8 * i + (lane >> 3); const float gg = g ? g[kk] : 1.f; LAS float* sp = scr + kk * 33 + 4 * (lane & 7);
        sp[0] = wv[i][0] * gg; sp[1] = wv[i][1] * gg; sp[2] = wv[i][2] * gg; sp[3] = wv[i][3] * gg; }
    asm volatile("s_waitcnt lgkmcnt(0)" ::: "memory");
    const int c = lane & 7;
#pragma unroll
    for (int j = 0; j < 4; ++j) { const int n = (lane >> 3) + 8 * j; const LAS float* sp = scr + (8 * c) * 33 + n;
        u32x4 o; o.x = cvtpk(sp[0 * 33], sp[1 * 33]); o.y = cvtpk(sp[2 * 33], sp[3 * 33]); o.z = cvtpk(sp[4 * 33], sp[5 * 33]); o.w = cvtpk(sp[6 * 33], sp[7 * 33]);
        const int nn = n0 + n; const int orow = mode == 0 ? nn : (mode == 3 ? (nn < 4096 ? nn : 4096 + (((nn - 4096) & 1023) >> 7) * 256 + (nn >= 5120 ? 128 : 0) + (nn & 127)) : ((nn >> 7) * 256 + (nn & 127) + (mode == 2 ? 128 : 0)));
        *(u32x4*)(WT + (size_t)orow * K + k0 + 8 * c) = o; }
    asm volatile("s_waitcnt lgkmcnt(0)" ::: "memory");
}
__device__ __forceinline__ void rms_row_to_bf16(const float* xrow, const float* g, bf16_t* orow, int lane) {
    const f32x4* xr = (const f32x4*)xrow + lane; const f32x4* gr = (const f32x4*)g + lane;
    f32x4 v[8]; float s = 0.f;
#pragma unroll
    for (int j = 0; j < 8; ++j) { v[j] = __builtin_nontemporal_load(xr + 64 * j); s += (v[j][0] * v[j][0] + v[j][1] * v[j][1]) + (v[j][2] * v[j][2] + v[j][3] * v[j][3]); }
    const float r = rsqrtf(wave_sum(s) * (1.f / 2048.f) + EPS);
    u32x2* o8 = (u32x2*)orow + lane;
#pragma unroll
    for (int j = 0; j < 8; ++j) { const f32x4 gg = gr[64 * j]; u32x2 o; o.x = cvtpk(v[j][0] * r * gg[0], v[j][1] * r * gg[1]); o.y = cvtpk(v[j][2] * r * gg[2], v[j][3] * r * gg[3]); o8[64 * j] = o; }
}
__device__ __forceinline__ void cvt_row_1024(const float* src, bf16_t* dst, float* fcopy, int lane) {
    const f32x4* xr = (const f32x4*)src + lane; u32x2* o8 = (u32x2*)dst + lane;
#pragma unroll
    for (int j = 0; j < 4; ++j) { const f32x4 v = xr[64 * j]; u32x2 o; o.x = cvtpk(v[0], v[1]); o.y = cvtpk(v[2], v[3]); o8[64 * j] = o; if (fcopy) ((f32x4*)fcopy + lane)[64 * j] = v; }
}

#define XB_TMO      128
#define XB_XCNT(j)  (256  + 64 * (j))
#define XB_XSUB(j)  (1280 + 64 * (j))
#define XB_XGEN(j)  (2304 + 64 * (j))
#define XB_TOP      3328
#define XB_TOPGEN   3392
#define XCD_BAR_WORDS 3456
#define XB_SPIN_CAP (1u << 20)
__device__ __forceinline__ unsigned xb_ld(unsigned* p)              { return __hip_atomic_load(p, __ATOMIC_RELAXED, __HIP_MEMORY_SCOPE_AGENT); }
__device__ __forceinline__ unsigned xb_add(unsigned* p, unsigned v) { return __hip_atomic_fetch_add(p, v, __ATOMIC_RELAXED, __HIP_MEMORY_SCOPE_AGENT); }
__device__ __forceinline__ unsigned xb_xcc_id() { return (unsigned)__builtin_amdgcn_s_getreg((3 << 11) | 20) & 0xFu; }
#define XB_SPIN(cond, bar) do { unsigned _sp = 0; while (cond) { __builtin_amdgcn_s_sleep(1); \
    if ((++_sp & 255u) == 0u) { if (xb_ld(&(bar)[XB_TMO])) break; if (_sp > XB_SPIN_CAP) { atomicAdd(&(bar)[XB_TMO], 1u); break; } } } } while (0)
struct XcdBarrier { unsigned* bar; unsigned x; volatile LAS unsigned* st; };
__device__ __forceinline__ XcdBarrier xcd_barrier_post(unsigned* bar, volatile LAS unsigned* st) {
    XcdBarrier b; b.bar = bar; b.x = xb_xcc_id(); b.st = st;
    if (threadIdx.x == 0) (void)xb_add(&bar[XB_XCNT(b.x)], 1u);
    return b;
}
__device__ __forceinline__ void xcd_barrier_complete(unsigned* bar, unsigned x, unsigned& nloc, unsigned& nx) {
    const unsigned G = gridDim.x * gridDim.y * gridDim.z;
    unsigned sum, cnt, mine, sp = 0u;
    for (;;) {
        sum = 0u; cnt = 0u; mine = 0u;
#pragma unroll
        for (unsigned j = 0; j < 16; ++j) { const unsigned c = xb_ld(&bar[XB_XCNT(j)]); sum += c; cnt += (c > 0u) ? 1u : 0u; mine = (j == x) ? c : mine; }
        if (sum == G) break;
        __builtin_amdgcn_s_sleep(1);
        if ((++sp & 255u) == 0u) { if (xb_ld(&bar[XB_TMO])) break; if (sp > XB_SPIN_CAP) { atomicAdd(&bar[XB_TMO], 1u); break; } }
    }
    nloc = mine > 0u ? mine : 1u; nx = cnt > 0u ? cnt : 1u;
}
__device__ __forceinline__ void xcd_barrier(const XcdBarrier& b) {
    asm volatile("s_waitcnt vmcnt(0)" ::: "memory");
    __syncthreads();
    if (threadIdx.x == 0) {
        unsigned* bar = b.bar;
        __builtin_amdgcn_s_waitcnt(0);
        unsigned nloc = b.st[0], nx = b.st[1];
        if (nloc == 0u) { xcd_barrier_complete(bar, b.x, nloc, nx); b.st[0] = nloc; b.st[1] = nx; }
        const unsigned old = xb_add(&bar[XB_XSUB(b.x)], 1u);
        const unsigned gen = old / nloc;
        if (old + 1u == (gen + 1u) * nloc) {
            __builtin_amdgcn_fence(__ATOMIC_RELEASE, "agent");
            asm volatile("s_waitcnt vmcnt(0)" ::: "memory");
            const unsigned og = xb_add(&bar[XB_TOP], 1u);
            const unsigned tg = og / nx;
            if (og + 1u == (tg + 1u) * nx) xb_add(&bar[XB_TOPGEN], 1u);
            else XB_SPIN(xb_ld(&bar[XB_TOPGEN]) == tg, bar);
            __builtin_amdgcn_fence(__ATOMIC_ACQUIRE, "agent");
            xb_add(&bar[XB_XGEN(b.x)], 1u);
            asm volatile("s_waitcnt vmcnt(0)" ::: "memory");
        } else {
            XB_SPIN(xb_ld(&bar[XB_XGEN(b.x)]) == gen, bar);
            __builtin_amdgcn_fence(__ATOMIC_ACQUIRE, "agent");
            asm volatile("s_waitcnt vmcnt(0)" ::: "memory");
        }
    }
    __syncthreads();
}

struct Args { const float* in[30]; float* out; unsigned char* ws; int ph_lo, ph_hi, li, pad; };

__global__ void __launch_bounds__(512, 2) fwd_kernel(Args a) {
    extern __shared__ __attribute__((aligned(16))) unsigned char lds_raw[];
    LAS unsigned char* lds = (LAS unsigned char*)lds_raw;
    cg::grid_group grid = cg::this_grid();
    const int tid = threadIdx.x, lane = tid & 63, wave = __builtin_amdgcn_readfirstlane(tid >> 6);
    const int G = gridDim.x, bid = blockIdx.x;
    const int gw = bid * 8 + wave, NGW = G * 8;
    unsigned char* ws = a.ws;
    const float *x_p = a.in[0], *x_s = a.in[1], *mem_p = a.in[2], *c_k = a.in[3], *c_v = a.in[4], *c_conv = a.in[5], *c_ffn = a.in[6], *c_mk = a.in[7], *c_mv = a.in[8];
    const float *g_norm1 = a.in[9], *w_in = a.in[10], *g_q = a.in[11], *g_k = a.in[12], *rel_bias = a.in[13], *w_cmix = a.in[14], *g_oa = a.in[15], *g_oc = a.in[16], *w_out = a.in[17];
    const float *g_norm2 = a.in[18], *g_memn = a.in[19], *w_xq = a.in[20], *w_xkv = a.in[21], *g_xq = a.in[22], *g_xk = a.in[23], *w_xo = a.in[24], *g_norm3 = a.in[25];
    const float *w_up = a.in[26], *w_gate = a.in[27], *w_fconv = a.in[28], *w_down = a.in[29];
    float* out = a.out;
    float* Y = out;
    float* o_pk = out + (size_t)MT * DM; float* o_pv = o_pk + 2097152; float* o_pc = o_pv + 2097152; float* o_pf = o_pc + 8192; float* o_pmk = o_pf + 45056; float* o_pmv = o_pmk + 1048576;
    float* o_sk = o_pmv + 1048576; float* o_sv = o_sk + 16777216; float* o_sc = o_sv + 16777216; float* o_sf = o_sc + 65536;
    float* SSA = (float*)(ws + WS_SSA); float* SSB = (float*)(ws + WS_SSB); float* SS2 = (float*)(ws + WS_SS2); float* SS3 = (float*)(ws + WS_SS3);
    bf16_t* WUG = (bf16_t*)(ws + WS_WUG); bf16_t* WDN = (bf16_t*)(ws + WS_WDN); bf16_t* WIN = (bf16_t*)(ws + WS_WIN); bf16_t* WOUT = (bf16_t*)(ws + WS_WOUT);
    bf16_t* WXQ = (bf16_t*)(ws + WS_WXQ); bf16_t* WXKV = (bf16_t*)(ws + WS_WXKV); bf16_t* WXO = (bf16_t*)(ws + WS_WXO);
    bf16_t* XN = (bf16_t*)(ws + WS_XN); bf16_t* HB = (bf16_t*)(ws + WS_HB); bf16_t* H2B = (bf16_t*)(ws + WS_H2B);
    bf16_t* QB = (bf16_t*)(ws + WS_QB); bf16_t* KA = (bf16_t*)(ws + WS_KA); bf16_t* VA = (bf16_t*)(ws + WS_VA); bf16_t* BBf = (bf16_t*)(ws + WS_BB); bf16_t* CBf = (bf16_t*)(ws + WS_CB); bf16_t* UBf = (bf16_t*)(ws + WS_UB);
    bf16_t* MIX = (bf16_t*)(ws + WS_MIX); bf16_t* QX = (bf16_t*)(ws + WS_QX); bf16_t* XO = (bf16_t*)(ws + WS_XO); bf16_t* UP = (bf16_t*)(ws + WS_UP); bf16_t* GATE = (bf16_t*)(ws + WS_GATE);
    float* TAILB = (float*)(ws + WS_TAIL); float* HEADU = (float*)(ws + WS_HEADU); float* HEADG = (float*)(ws + WS_HEADG);
    bf16_t* MEMN = (bf16_t*)(ws + WS_MEMN); bf16_t* MKA = (bf16_t*)(ws + WS_MKA); bf16_t* MVA = (bf16_t*)(ws + WS_MVA);
    LAS float* XCH = (LAS float*)(lds + XCH_OFF);
    const int lo = a.ph_lo, hi_ph = a.ph_hi;
#ifdef ONLY_PHASE
#define IN(k) ((k) == ONLY_PHASE && lo <= (k) && (k) < hi_ph)
#else
#define IN(k) (lo <= (k) && (k) < hi_ph)
#endif
#define SEAM(k) do { if (IN(k) && IN((k) + 1)) xcd_barrier(xbar); } while (0)
    if (a.ph_hi < 0) grid.sync();
    volatile LAS unsigned* MISC = (volatile LAS unsigned*)(lds + MISC_OFF);
    if (tid < 2) MISC[tid] = 0u;
    __syncthreads();
    XcdBarrier xbar = xcd_barrier_post((unsigned*)ws + a.li * XCD_BAR_WORDS, MISC);

    if (IN(0)) {
        LAS float* scr = (LAS float*)(lds + wave * 16384);
        constexpr int I_UP = 32 * 176, I_DN = 88 * 64, I_IN = 32 * 192, I_OUT = 32 * 64, I_XQ = 32 * 32, I_XKV = 32 * 64, I_XO = 16 * 64;
        constexpr int T0 = I_UP, T1 = T0 + I_UP, T2 = T1 + I_DN, T3 = T2 + I_IN, T4 = T3 + I_OUT, T5 = T4 + I_XQ, T6 = T5 + I_XKV, T7 = T6 + I_XO;
        for (int it = gw; it < T7; it += NGW) {
            if (it < T0) p0_transpose_item(w_up, DM, DFF, WUG, 1, g_norm3, g_norm3, 1 << 30, scr, it, lane);
            else if (it < T1) p0_transpose_item(w_gate, DM, DFF, WUG, 2, g_norm3, g_norm3, 1 << 30, scr, it - T0, lane);
            else if (it < T2) p0_transpose_item(w_down, DFF, DM, WDN, 0, nullptr, nullptr, 0, scr, it - T1, lane);
            else if (it < T3) p0_transpose_item(w_in, DM, 6144, WIN, 3, nullptr, nullptr, 0, scr, it - T2, lane);
            else if (it < T4) p0_transpose_item(w_out, DM, DM, WOUT, 0, g_oa, g_oc, 1024, scr, it - T3, lane);
            else if (it < T5) p0_transpose_item(w_xq, DM, 1024, WXQ, 0, g_norm2, g_norm2, 1 << 30, scr, it - T4, lane);
            else if (it < T6) p0_transpose_item(w_xkv, DM, DM, WXKV, 0, nullptr, nullptr, 0, scr, it - T5, lane);
            else p0_transpose_item(w_xo, 1024, DM, WXO, 0, nullptr, nullptr, 0, scr, it - T6, lane);
        }
        for (int r = gw; r < MT + 1024; r += NGW) {
            const float* src = r < NPR ? x_p + (size_t)r * DM : (r < MT ? x_s + (size_t)(r - NPR) * DM : mem_p + (size_t)(r - MT) * DM);
            rms_row_to_bf16(src, r < MT ? g_norm1 : g_memn, (r < MT ? XN : MEMN - (size_t)MT * DM) + (size_t)r * DM, lane);
        }
        for (int r4 = gw; r4 < (2 * 16384 + 2 * 8192) / 4; r4 += NGW) {
            f32x4 v[4][4]; bf16_t* dst[4]; float* fc[4];
#pragma unroll
            for (int q = 0; q < 4; ++q) { const int r = r4 * 4 + q; const float* src;
                if (r < 32768) { const int kv = r >> 14, rr = r & 16383, b = rr >> 9, j = rr & 511;
                    src = (kv ? c_v : c_k) + (size_t)rr * 1024; dst[q] = (kv ? VA : KA) + ((size_t)NPR + (size_t)b * 576 + j) * 1024;
                    fc[q] = j >= 64 ? (kv ? o_sv : o_sk) + ((size_t)b * 512 + j - 64) * 1024 : nullptr; }
                else { const int r2 = r - 32768, kv = r2 >> 13, rr = r2 & 8191; src = (kv ? c_mv : c_mk) + (size_t)rr * 1024; dst[q] = (kv ? MVA : MKA) + ((size_t)1024 + rr) * 1024; fc[q] = nullptr; }
#pragma unroll
                for (int j = 0; j < 4; ++j) v[q][j] = __builtin_nontemporal_load((const f32x4*)src + lane + 64 * j); }
#pragma unroll
            for (int q = 0; q < 4; ++q)
#pragma unroll
                for (int j = 0; j < 4; ++j) { u32x2 o; o.x = cvtpk(v[q][j][0], v[q][j][1]); o.y = cvtpk(v[q][j][2], v[q][j][3]); ((u32x2*)dst[q] + lane)[64 * j] = o; if (fc[q]) __builtin_nontemporal_store(v[q][j], (f32x4*)fc[q] + lane + 64 * j); }
        }
    }
    SEAM(0);

    if (IN(1)) {
        Order S; S.init(MT, 6144, G, bid, 1024, 8);
        EpiP1 E{XCH, QB, KA, VA, BBf, CBf, UBf, MKA, MVA, o_pk, o_pv, o_sk, o_sv, o_pmk, o_pmv, g_q, g_k, g_xk, 0.08838834764831845f * LOG2E};
        gemm_phase<EpiP1>(lds, XN, WIN, MEMN, WXKV, DM, S, E);
    }
    SEAM(1);

    if (IN(2)) {
        LAS float* btab = (LAS float*)(lds + BT_OFF);
        {
            const float gqm = wave_max(fmaxf(fabsf(g_q[lane]), fabsf(g_q[lane + 64]))), gkm = wave_max(fmaxf(fabsf(g_k[lane]), fabsf(g_k[lane + 64])));
            float tm = -1e30f; for (int j = lane; j < 257; j += 64) tm = fmaxf(tm, rel_bias[wave * 257 + j]);
            tm = wave_max(tm);
            const float Mh = 11.313708498984761f * gqm * gkm * 1.01f + tm;
            for (int j = lane; j < 257; j += 64) btab[wave * 264 + j] = (rel_bias[wave * 257 + j] - Mh) * LOG2E;
        }
        asm volatile("s_waitcnt lgkmcnt(0)" ::: "memory"); __builtin_amdgcn_s_barrier(); asm volatile("" ::: "memory");
        for (int un = bid; un < 1024 + 256; un += G) {
            if (un < 1024) { const int h = un & 7, bg = un >> 3, b = bg >> 5, c0 = (bg & 31) * 4, klo = c0 > 8 ? c0 - 8 : 0;
                const size_t krow0 = (size_t)b * SEQ + 64 * klo, qrow0 = (size_t)b * SEQ + 64 * c0;
                band_unit<8>(lds, KA + krow0 * 1024 + h * 128, VA + krow0 * 1024 + h * 128, 2 * (c0 + 4 - klo), QB + qrow0 * 1024 + h * 128, MIX + qrow0 * DM + h * 128, SSA + qrow0 * 8 + h, 4, c0 - klo, btab + h * 264); }
            else { const int su = un - 1024, h = su & 7, b = su >> 3;
                const size_t krow0 = (size_t)NPR + (size_t)b * 576, qrow0 = (size_t)NPR + 64 * b;
                band_unit<8>(lds, KA + krow0 * 1024 + h * 128, VA + krow0 * 1024 + h * 128, 18, QB + qrow0 * 1024 + h * 128, MIX + qrow0 * DM + h * 128, SSA + qrow0 * 8 + h, 1, 8, btab + h * 264); }
        }
    }
    SEAM(2);

    if (IN(3)) {
        for (int r = gw; r < MT; r += NGW) {
            { const f32x4 a0 = *(const f32x4*)(SSA + (size_t)r * 8), a1 = *(const f32x4*)(SSA + (size_t)r * 8 + 4);
              const float ra = rsqrtf(((a0[0] + a0[1]) + (a0[2] + a0[3]) + (a1[0] + a1[1]) + (a1[2] + a1[3])) * (1.f / 1024.f) + EPS);
              bf16_t* mp = MIX + (size_t)r * DM + lane * 16;
              u32x4 m0 = *(const u32x4*)mp, m1 = *(const u32x4*)(mp + 8);
#pragma unroll
              for (int i = 0; i < 4; ++i) { m0[i] = cvtpk(bflo(m0[i]) * ra, bfhi(m0[i]) * ra); m1[i] = cvtpk(bflo(m1[i]) * ra, bfhi(m1[i]) * ra); }
              *(u32x4*)mp = m0; *(u32x4*)(mp + 8) = m1; }
            int t, b; const bool smp = r >= NPR;
            if (!smp) { t = r & (SEQ - 1); b = r >> 13; } else { t = (r - NPR) & 63; b = (r - NPR) >> 6; }
            const int ch = lane * 16;
            float cu0[16], cu1[16], cu2[16], bv[16];
            { const u32x4 c0 = *(const u32x4*)(CBf + (size_t)r * 1024 + ch), c1 = *(const u32x4*)(CBf + (size_t)r * 1024 + ch + 8);
              const u32x4 b0 = *(const u32x4*)(BBf + (size_t)r * 1024 + ch), b1 = *(const u32x4*)(BBf + (size_t)r * 1024 + ch + 8);
#pragma unroll
              for (int i = 0; i < 4; ++i) { cu0[2 * i] = bflo(c0[i]); cu0[2 * i + 1] = bfhi(c0[i]); cu0[8 + 2 * i] = bflo(c1[i]); cu0[8 + 2 * i + 1] = bfhi(c1[i]);
                  bv[2 * i] = bflo(b0[i]); bv[2 * i + 1] = bfhi(b0[i]); bv[8 + 2 * i] = bflo(b1[i]); bv[8 + 2 * i + 1] = bfhi(b1[i]); } }
#pragma unroll
            for (int k = 1; k <= 2; ++k) {
                float* d = k == 1 ? cu1 : cu2;
                if (t - k >= 0) { const size_t rr = (size_t)(r - k) * 1024 + ch;
                    const u32x4 c0 = *(const u32x4*)(CBf + rr), c1 = *(const u32x4*)(CBf + rr + 8);
#pragma unroll
                    for (int i = 0; i < 4; ++i) { d[2 * i] = bflo(c0[i]); d[2 * i + 1] = bfhi(c0[i]); d[8 + 2 * i] = bflo(c1[i]); d[8 + 2 * i + 1] = bfhi(c1[i]); } }
                else if (smp) { const float* cp = c_conv + ((size_t)b * 2 + (2 + t - k)) * 1024 + ch;
#pragma unroll
                    for (int i = 0; i < 16; ++i) d[i] = cp[i]; }
                else {
#pragma unroll
                    for (int i = 0; i < 16; ++i) d[i] = 0.f; }
            }
            float ss = 0.f; unsigned ow[8];
#pragma unroll
            for (int cc = 0; cc < 16; ++cc) { const float cv = w_cmix[ch + cc] * cu2[cc] + w_cmix[1024 + ch + cc] * cu1[cc] + w_cmix[2048 + ch + cc] * cu0[cc]; bv[cc] *= cv; ss += bv[cc] * bv[cc]; }
            const float rbn = rsqrtf(wave_sum(ss) * (1.f / 1024.f) + EPS);
#pragma unroll
            for (int i = 0; i < 8; ++i) ow[i] = cvtpk(bv[2 * i] * rbn, bv[2 * i + 1] * rbn);
            *(u32x4*)(MIX + (size_t)r * DM + 1024 + ch) = (u32x4){ow[0], ow[1], ow[2], ow[3]}; *(u32x4*)(MIX + (size_t)r * DM + 1024 + ch + 8) = (u32x4){ow[4], ow[5], ow[6], ow[7]};
            float* cvo = nullptr;
            if (!smp) { if (t >= SEQ - 2) cvo = o_pc + ((size_t)b * 2 + (t - (SEQ - 2))) * 1024; } else if (t >= 62) cvo = o_sc + ((size_t)b * 2 + (t - 62)) * 1024;
            if (cvo) {
#pragma unroll
                for (int i = 0; i < 4; ++i) *(f32x4*)(cvo + ch + 4 * i) = (f32x4){cu0[4 * i], cu0[4 * i + 1], cu0[4 * i + 2], cu0[4 * i + 3]}; }
        }
    }
    SEAM(3);

    if (IN(4)) {
        Order S; S.init(MT, DM, G, bid);
        EpiP3 E{XCH, x_p, x_s, HB, SS2};
        gemm_phase<EpiP3>(lds, MIX, WOUT, MIX, WOUT, DM, S, E);
    }
    SEAM(4);

    if (IN(5)) {
        Order S; S.init(MT, 1024, G, bid);
        EpiP4 E{XCH, SS2, g_xq, QX, 0.0625f * LOG2E};
        gemm_phase<EpiP4>(lds, HB, WXQ, HB, WXQ, DM, S, E);
    }
    SEAM(5);

    if (IN(6)) {
        float gm1 = fmaxf(fmaxf(fabsf(g_xq[lane]), fabsf(g_xq[lane + 64])), fmaxf(fabsf(g_xq[lane + 128]), fabsf(g_xq[lane + 192])));
        float gm2 = fmaxf(fmaxf(fabsf(g_xk[lane]), fabsf(g_xk[lane + 64])), fmaxf(fabsf(g_xk[lane + 128]), fabsf(g_xk[lane + 192])));
        const float cinit = -(16.f * wave_max(gm1) * wave_max(gm2) * 1.01f) * LOG2E;
        for (int un = bid; un < 1024 + 128; un += G) {
            size_t krow0, qrow0; int h, nq;
            if (un < 1024) { const int qt = un >> 2; h = un & 3; krow0 = (size_t)(qt >> 6) * 256; qrow0 = (size_t)qt * 128; nq = 128; }
            else { const int su = un - 1024, b = su >> 2; h = su & 3; krow0 = (size_t)(4 + b) * 256; qrow0 = (size_t)NPR + 64 * b; nq = 64; }
            attn_unit<2, 1, false>(lds, MKA + krow0 * 1024, MVA + krow0 * 1024, h * 256, 8, QX + qrow0 * 1024, nq, XO + qrow0 * 1024, 1024, nullptr, 0, 0, (const LAS float*)(lds + BT_OFF), cinit);
        }
    }
    SEAM(6);

    if (IN(7)) {
        Order S; S.init(MT, DM, G, bid);
        EpiP6 E{XCH, H2B, SS3};
        gemm_phase<EpiP6>(lds, XO, WXO, XO, WXO, 1024, S, E);
    }
    SEAM(7);

    if (IN(8)) {
        Order S; S.init(MT, 2 * DFF, G, bid);
        EpiP7 E{XCH, SS3, GATE, o_pf, o_sf, c_ffn, w_fconv, TAILB, HEADU, HEADG};
        gemm_phase<EpiP7>(lds, H2B, WUG, H2B, WUG, DM, S, E);
    }
    SEAM(8);

    if (IN(9)) {
        for (int it = gw; it < 128 * 11; it += NGW) {
            const int pm = it / 11, sl = it % 11, f = sl * 512 + lane * 8;
            if ((pm & 31) == 0) continue;
            const float* t0 = TAILB + ((size_t)(pm - 1) * 2) * DFF + f; const float* hu = HEADU + ((size_t)pm * 2) * DFF + f; const float* hg = HEADG + ((size_t)pm * 2) * DFF + f;
            float a0[8], a1[8];
#pragma unroll
            for (int i = 0; i < 8; ++i) { const float x2 = t0[i], x1 = t0[DFF + i], c0 = hu[i], c1 = hu[DFF + i];
                const float w0 = w_fconv[f + i], w1 = w_fconv[DFF + f + i], w2 = w_fconv[2 * DFF + f + i];
                a0[i] = silu_mul(w0 * x2 + w1 * x1 + w2 * c0, hg[i]); a1[i] = silu_mul(w0 * x1 + w1 * c0 + w2 * c1, hg[DFF + i]); }
            *(u32x4*)(GATE + (size_t)pm * BM * DFF + f) = (u32x4){cvtpk(a0[0], a0[1]), cvtpk(a0[2], a0[3]), cvtpk(a0[4], a0[5]), cvtpk(a0[6], a0[7])};
            *(u32x4*)(GATE + ((size_t)pm * BM + 1) * DFF + f) = (u32x4){cvtpk(a1[0], a1[1]), cvtpk(a1[2], a1[3]), cvtpk(a1[4], a1[5]), cvtpk(a1[6], a1[7])};
        }
    }
    SEAM(9);

    if (IN(10)) {
        Order S; S.init(MT, DM, G, bid, 0, 1, 1024, 4);
        EpiP9 E{Y, H2B, (float*)(ws + WS_UP)};
        gemm_phase<EpiP9>(lds, GATE, WDN, GATE, WDN, DFF, S, E);
    }
    SEAM(10);

    if (IN(11)) {
        Order S; S.init(MT, DM, G, bid, 0, 1, 1024, 4);
        const float* PART = (const float*)(ws + WS_UP);
        for (int wi = gw; wi < 64 * 256; wi += NGW) { const int tl = wi >> 8, row = wi & 255; int pm, pn; S.map(1024 + tl, pm, pn);
            const unsigned off = (unsigned)(pm * BM + row) * DM + pn * BM + lane * 4;
            const u32x2 h = *(const u32x2*)(H2B + off);
            const float* pp = PART + (size_t)tl * 4 * 65536 + row * 256 + lane * 4;
            const f32x4 p0 = *(const f32x4*)pp, p1 = *(const f32x4*)(pp + 65536), p2 = *(const f32x4*)(pp + 2 * 65536), p3 = *(const f32x4*)(pp + 3 * 65536);
            *(f32x4*)(Y + off) = (f32x4){bflo(h.x), bfhi(h.x), bflo(h.y), bfhi(h.y)} + ((p0 + p1) + (p2 + p3)); }
    }
#undef IN
#undef SEAM
}

extern "C" void kernel_launch(void* const* d_in, const int* in_sizes, int n_in, void* d_out, int out_size, void* d_ws, size_t ws_size, hipStream_t stream) {
    static int grid = 0;
    if (grid == 0) {
        int dev = 0, cus = 0, per_cu = 0;
        if (n_in != 30 || ws_size < WS_END) { fprintf(stderr, "kernel_launch: unexpected n_in %d or ws %zu\n", n_in, ws_size); grid = -1; return; }
        (void)hipGetDevice(&dev);
        (void)hipDeviceGetAttribute(&cus, hipDeviceAttributeMultiprocessorCount, dev);
        (void)hipFuncSetAttribute((const void*)fwd_kernel, hipFuncAttributeMaxDynamicSharedMemorySize, LDS_BYTES);
        (void)hipOccupancyMaxActiveBlocksPerMultiprocessor(&per_cu, (const void*)fwd_kernel, 512, LDS_BYTES);
        if (per_cu < 1) per_cu = 1;
        grid = cus * per_cu;
    }
    if (grid < 0) return;
    (void)hipMemsetAsync(d_ws, 0, 65536, stream);
    Args a{};
    for (int i = 0; i < 30; ++i) a.in[i] = (const float*)d_in[i];
    a.out = (float*)d_out; a.ws = (unsigned char*)d_ws; a.ph_lo = 0; a.ph_hi = 12;
    void* args[] = {&a};
#ifdef PROBE_PH
    a.ph_hi = PROBE_PH + 1;
    (void)hipLaunchCooperativeKernel((const void*)fwd_kernel, dim3(grid), dim3(512), args, LDS_BYTES, stream);
    for (int r = 0; r < PROBE_N; ++r) { a.ph_lo = PROBE_PH; a.ph_hi = PROBE_PH + 1; a.li = 1 + r; (void)hipLaunchCooperativeKernel((const void*)fwd_kernel, dim3(grid), dim3(512), args, LDS_BYTES, stream); }
    a.ph_lo = PROBE_PH + 1; a.ph_hi = 12; a.li = 1 + PROBE_N;
#endif
    hipError_t e = hipLaunchCooperativeKernel((const void*)fwd_kernel, dim3(grid), dim3(512), args, LDS_BYTES, stream);
    if (e != hipSuccess) fprintf(stderr, "cooperative launch failed: %s (grid %d)\n", hipGetErrorString(e), grid);
}
```

```cpp
#include <hip/hip_runtime.h>
#include <hip/hip_cooperative_groups.h>
#include <cstdio>
#include <cstdint>
namespace cg = cooperative_groups;

#define LAS __attribute__((address_space(3)))
typedef unsigned short bf16_t;
typedef short bf16x8 __attribute__((ext_vector_type(8)));
typedef short s16x4 __attribute__((ext_vector_type(4)));
typedef float f32x4 __attribute__((ext_vector_type(4)));
typedef float f32x2 __attribute__((ext_vector_type(2)));
typedef float f32x16 __attribute__((ext_vector_type(16)));
typedef unsigned u32x4 __attribute__((ext_vector_type(4)));
typedef unsigned u32x2 __attribute__((ext_vector_type(2)));
typedef __bf16 bf16x2_t __attribute__((ext_vector_type(2)));

constexpr int DM = 2048, NPR = 32768, MT = 34816, DFF = 5632, SEQ = 8192;
constexpr float EPS = 1e-6f, LOG2E = 1.4426950408889634f;
constexpr int KROWS = NPR + 32 * 576;

constexpr size_t MiB = 1u << 20;
constexpr size_t WS_SSA = 1 * MiB, WS_SSB = 3 * MiB, WS_SS2 = 4 * MiB, WS_SS3 = 6 * MiB;
constexpr size_t WS_WUG = 16 * MiB, WS_WDN = 60 * MiB;
constexpr size_t WS_XN = 82 * MiB, WS_HB = 82 * MiB, WS_H2B = 82 * MiB;
constexpr size_t WS_QB = 218 * MiB, WS_KA = 286 * MiB, WS_VA = 386 * MiB, WS_BB = 486 * MiB, WS_CB = 554 * MiB, WS_UB = 622 * MiB;
constexpr size_t WS_MIX = 698 * MiB;
constexpr size_t WS_QX = 218 * MiB, WS_XO = 286 * MiB;
constexpr size_t WS_UP = 218 * MiB, WS_GATE = 592 * MiB;
constexpr size_t WS_TAIL = 966 * MiB, WS_HEADU = 974 * MiB, WS_HEADG = 982 * MiB;
constexpr size_t WS_MEMN = 926 * MiB, WS_MKA = 930 * MiB, WS_MVA = 948 * MiB;
constexpr size_t WS_WIN = 966 * MiB, WS_WOUT = 990 * MiB, WS_WXQ = 998 * MiB, WS_WXKV = 1002 * MiB, WS_WXO = 1010 * MiB, WS_END = 1014 * MiB;

constexpr int RING_BYTES = 131072, XCH_OFF = 131072, BT_OFF = XCH_OFF + 8192, LSC_OFF = BT_OFF + 8 * 264 * 4, MISC_OFF = LSC_OFF + 8 * 32 * 4, LDS_BYTES = 153600;
static_assert(MISC_OFF + 64 <= LDS_BYTES, "lds map");

__device__ __forceinline__ unsigned cvtpk(float lo, float hi) { f32x2 v = {lo, hi}; bf16x2_t b = __builtin_convertvector(v, bf16x2_t); return __builtin_bit_cast(unsigned, b); }
__device__ __forceinline__ unsigned f2bf(float f) { unsigned u = __builtin_bit_cast(unsigned, f); return (u + 0x7fffu + ((u >> 16) & 1u)) >> 16; }
__device__ __forceinline__ float bflo(unsigned w) { return __builtin_bit_cast(float, w << 16); }
__device__ __forceinline__ float bfhi(unsigned w) { return __builtin_bit_cast(float, w & 0xffff0000u); }
__device__ __forceinline__ float wave_sum(float v) {
#pragma unroll
    for (int o = 1; o < 64; o <<= 1) v += __shfl_xor(v, o);
    return v;
}
__device__ __forceinline__ float wave_max(float v) {
#pragma unroll
    for (int o = 1; o < 64; o <<= 1) v = fmaxf(v, __shfl_xor(v, o));
    return v;
}
__device__ __forceinline__ u32x4 pack8(f32x4 a, f32x4 b) { u32x4 w; w.x = cvtpk(a[0], a[1]); w.y = cvtpk(a[2], a[3]); w.z = cvtpk(b[0], b[1]); w.w = cvtpk(b[2], b[3]); return w; }

constexpr int BM = 256, BK = 64, HALF = 128, HTB = HALF * BK * 2, NXCD = 8, WGM = 4;
__device__ __forceinline__ int lds_byte(int r, int c) { const int st = (r >> 4) * 2 + (c >> 5), rr = r & 15, cc = c & 31, ob = rr * 64 + cc * 2; return st * 1024 + (ob ^ (((ob >> 9) & 1) << 5)); }
__device__ __forceinline__ void stage_rc(int b, int& R, int& C) { const int st = b / 1024, sb = b % 1024, swz = sb ^ (((sb >> 9) & 1) << 5); R = (st >> 1) * 16 + swz / 64; C = (st & 1) * 32 + (swz % 64) / 2; }
__device__ __forceinline__ int perm32(int rho) { const int n = rho >> 4, i = rho & 15; return 8 * (i >> 2) + 4 * n + (i & 3); }

struct Unit { int pm, pn, gid, ks, tail; };
struct Order {
    int nM, nN, nwg, G, c, nex, exN, nfull, nsplit;
    __device__ __forceinline__ void init(int M, int N, int G_, int c_, int exM = 0, int exN_ = 1, int nfull_ = -1, int nsplit_ = 1) { nM = M / BM; nN = N / BM; nwg = nM * nN; G = G_; c = c_; exN = exN_; nex = (exM / BM) * exN_;
        nfull = nfull_ < 0 ? nwg : nfull_; nsplit = nsplit_; }
    __device__ __forceinline__ void map(int wgid, int& pm, int& pn) const {
        { const int q = nwg / NXCD, r = nwg % NXCD, xcd = wgid % NXCD, off = wgid / NXCD; wgid = (xcd < r ? xcd * (q + 1) : r * (q + 1) + (xcd - r) * q) + off; }
        const int nig = WGM * nN, gidx = wgid / nig, fm = gidx * WGM, gsz = (nM - fm) < WGM ? (nM - fm) : WGM;
        pm = fm + ((wgid % nig) % gsz); pn = (wgid % nig) / gsz;
    }
    __device__ __forceinline__ bool next(int i, Unit& u) const {
        const int L = i * G + c, nmain = nfull + (nwg - nfull) * nsplit; const bool ok = L < nmain + nex; const bool ex = L >= nmain;
        const int e = ex ? L - nmain : 0;
        const bool sp = !ex && L >= nfull; const int es = sp ? L - nfull : 0;
        const int wgid = ex ? 0 : (sp ? nfull + es / nsplit : L);
        int pm0, pn0; map(wgid, pm0, pn0);
        u.pm = ex ? e / exN : pm0; u.pn = ex ? e % exN : pn0; u.gid = ex ? 1 : 0; u.ks = sp ? es % nsplit : -1; u.tail = sp ? es / nsplit : 0;
        return ok;
    }
};

#define EPI_BAR() do { asm volatile("s_waitcnt lgkmcnt(0)" ::: "memory"); __builtin_amdgcn_s_barrier(); asm volatile("" ::: "memory"); } while (0)

__device__ __forceinline__ void head_ss(const f32x4 (&v)[2][2][4][2], float (&tot)[2][4][2], LAS float* X, int wr, int wc, int fr, int fq) {
#pragma unroll
    for (int ai = 0; ai < 2; ++ai)
#pragma unroll
        for (int m = 0; m < 4; ++m)
#pragma unroll
            for (int bj = 0; bj < 2; ++bj) {
                const f32x4 a = v[ai][bj][m][0], b = v[ai][bj][m][1];
                float s = (a[0] * a[0] + a[1] * a[1]) + (a[2] * a[2] + a[3] * a[3]) + (b[0] * b[0] + b[1] * b[1]) + (b[2] * b[2] + b[3] * b[3]);
                s += __shfl_xor(s, 16); s += __shfl_xor(s, 32);
                if (fq == 0) X[((ai * 128 + wr * 64 + m * 16 + fr) * 2 + bj) * 4 + wc] = s;
            }
    EPI_BAR();
#pragma unroll
    for (int ai = 0; ai < 2; ++ai)
#pragma unroll
        for (int m = 0; m < 4; ++m)
#pragma unroll
            for (int bj = 0; bj < 2; ++bj) { const f32x4 t = *(const LAS f32x4*)(X + ((ai * 128 + wr * 64 + m * 16 + fr) * 2 + bj) * 4); tot[ai][m][bj] = (t[0] + t[1]) + (t[2] + t[3]); }
}

template <class Epi>
__device__ __forceinline__ void gemm_phase(LAS unsigned char* lds, const bf16_t* A0, const bf16_t* B0, const bf16_t* A1, const bf16_t* B1, const int K, const Order& S, const Epi& E) {
    const int tid = threadIdx.x, wid = __builtin_amdgcn_readfirstlane(tid >> 6), lane = tid & 63, wr = wid >> 2, wc = wid & 3, fr = lane & 15, fq = lane >> 4;
    const int nt = K / BK;
    unsigned voffA[2], voffB[2];
#pragma unroll
    for (int i = 0; i < 2; ++i) { int R, C; stage_rc(tid * 16 + i * 8192, R, C); const int Rb = (R & ~31) + perm32(R & 31);
        voffA[i] = (unsigned)(R * K + C) * 2u; voffB[i] = (unsigned)(Rb * K + C) * 2u; }
    const size_t kstep = (size_t)(BK * 2);
    const size_t hstep = (size_t)HALF * K * 2;
    const size_t tstep = 2 * hstep;
    const unsigned ldsw = (unsigned)wid * 1024u;
    const int aoff = lds_byte(wr * 64 + fr, fq * 8), boff = lds_byte(wc * 32 + fr, fq * 8);
#define PG8_SA(b, h) (((b) * 2 + (h)) * HTB)
#define PG8_SB(b, h) ((4 + (b) * 2 + (h)) * HTB)
#define PG8_STAGE(bufoff, gbase, voff) do { _Pragma("unroll") for (int _i = 0; _i < 2; ++_i) \
        __builtin_amdgcn_global_load_lds((const unsigned*)((const char*)(gbase) + (voff)[_i]), (LAS unsigned*)(lds + (bufoff) + ldsw + _i * 8192), 16, 0, 0); } while (0)
#define PG8_LDA(dst, b, h) do { _Pragma("unroll") for (int m = 0; m < 4; ++m) _Pragma("unroll") for (int k = 0; k < 2; ++k) dst[m][k] = *(const LAS bf16x8*)(lds + PG8_SA(b, h) + aoff + m * 2048 + k * 1024); } while (0)
#define PG8_LDB(dst, b, h) do { _Pragma("unroll") for (int n = 0; n < 2; ++n) _Pragma("unroll") for (int k = 0; k < 2; ++k) dst[n][k] = *(const LAS bf16x8*)(lds + PG8_SB(b, h) + boff + n * 2048 + k * 1024); } while (0)
#define PG8_MMA(ai, bj, At, Bt) do { __builtin_amdgcn_s_setprio(1); _Pragma("unroll") for (int m = 0; m < 4; ++m) _Pragma("unroll") for (int n = 0; n < 2; ++n) _Pragma("unroll") for (int k = 0; k < 2; ++k) \
        acc[ai][bj][m][n] = __builtin_amdgcn_mfma_f32_16x16x32_bf16(Bt[n][k], At[m][k], acc[ai][bj][m][n], 0, 0, 0); __builtin_amdgcn_s_setprio(0); } while (0)
#define PG8_WAIT_V(n) asm volatile("s_waitcnt vmcnt(" #n ")" ::: "memory")
#define PG8_WAIT_L(n) asm volatile("s_waitcnt lgkmcnt(" #n ")" ::: "memory")
#define PG8_BAR __builtin_amdgcn_s_barrier()
#define PG8_SCHED __builtin_amdgcn_sched_barrier(0)
    Unit cur, nxt; int ui = 0;
    if (!S.next(0, cur)) return;
    f32x4 acc[2][2][4][2];
#pragma unroll
    for (int a = 0; a < 2; ++a)
#pragma unroll
        for (int b = 0; b < 2; ++b)
#pragma unroll
            for (int m = 0; m < 4; ++m)
#pragma unroll
                for (int n = 0; n < 2; ++n) acc[a][b][m][n] = (f32x4){0.f, 0.f, 0.f, 0.f};
    bf16x8 At[4][2], Bf0[2][2], Bf1[2][2];
    const int ntq = nt / S.nsplit;
    const char* cA = (const char*)(cur.gid ? A1 : A0) + (size_t)cur.pm * tstep + (cur.ks > 0 ? (size_t)cur.ks * ntq * kstep : 0); const char* cB = (const char*)(cur.gid ? B1 : B0) + (size_t)cur.pn * tstep + (cur.ks > 0 ? (size_t)cur.ks * ntq * kstep : 0);
    PG8_STAGE(PG8_SB(0, 0), cB, voffB); PG8_STAGE(PG8_SB(0, 1), cB + hstep, voffB); PG8_STAGE(PG8_SA(0, 0), cA, voffA); PG8_STAGE(PG8_SA(0, 1), cA + hstep, voffA);
    if (wr == 1) PG8_BAR;
    PG8_WAIT_V(2); PG8_BAR;
    PG8_STAGE(PG8_SB(1, 0), cB + kstep, voffB); PG8_STAGE(PG8_SA(1, 0), cA + kstep, voffA); PG8_STAGE(PG8_SB(1, 1), cB + hstep + kstep, voffB);
    PG8_WAIT_V(6); PG8_BAR;
    for (;;) {
        const bool has_next = S.next(ui + 1, nxt);
        const size_t nko = (has_next && nxt.ks > 0) ? (size_t)nxt.ks * ntq * kstep : 0;
        const char* nA = has_next ? (const char*)(nxt.gid ? A1 : A0) + (size_t)nxt.pm * tstep + nko : cA; const char* nB = has_next ? (const char*)(nxt.gid ? B1 : B0) + (size_t)nxt.pn * tstep + nko : cB;
        const int cnt = cur.ks < 0 ? nt : ntq;
        for (int t = 0; t < cnt; t += 2) {
            const bool last = (t == cnt - 2);
            const char* a1 = cA + (size_t)(t + 1) * kstep;
            const char* a2 = last ? nA : cA + (size_t)(t + 2) * kstep; const char* b2 = last ? nB : cB + (size_t)(t + 2) * kstep;
            const char* a3 = a2 + kstep; const char* b3 = b2 + kstep;
            PG8_LDB(Bf0, 0, 0); PG8_LDB(Bf1, 0, 1); PG8_SCHED; PG8_LDA(At, 0, 0); PG8_STAGE(PG8_SA(1, 1), a1 + hstep, voffA);
            PG8_WAIT_V(8); PG8_WAIT_L(0); PG8_BAR; PG8_MMA(0, 0, At, Bf0); PG8_MMA(0, 1, At, Bf1); PG8_BAR; PG8_SCHED;
            PG8_LDA(At, 0, 1); PG8_STAGE(PG8_SB(0, 0), b2, voffB); PG8_STAGE(PG8_SB(0, 1), b2 + hstep, voffB); PG8_STAGE(PG8_SA(0, 0), a2, voffA);
            PG8_WAIT_V(8); PG8_WAIT_L(0); PG8_BAR; PG8_MMA(1, 0, At, Bf0); PG8_MMA(1, 1, At, Bf1); PG8_BAR; PG8_SCHED;
            PG8_LDB(Bf0, 1, 0); PG8_LDB(Bf1, 1, 1); PG8_SCHED; PG8_LDA(At, 1, 0); PG8_STAGE(PG8_SA(0, 1), a2 + hstep, voffA);
            PG8_WAIT_V(8); PG8_WAIT_L(0); PG8_BAR; PG8_MMA(0, 0, At, Bf0); PG8_MMA(0, 1, At, Bf1); PG8_BAR; PG8_SCHED;
            PG8_LDA(At, 1, 1); PG8_STAGE(PG8_SB(1, 0), b3, voffB); PG8_STAGE(PG8_SB(1, 1), b3 + hstep, voffB); PG8_STAGE(PG8_SA(1, 0), a3, voffA);
            PG8_WAIT_V(8); PG8_WAIT_L(0); PG8_BAR; PG8_MMA(1, 0, At, Bf0); PG8_MMA(1, 1, At, Bf1); PG8_BAR; PG8_SCHED;
        }
        if (wr == 0) PG8_BAR;
        PG8_WAIT_V(0);
        E(acc, cur, wr, wc, fr, fq);
        if (!has_next) break;
#pragma unroll
        for (int a = 0; a < 2; ++a)
#pragma unroll
            for (int b = 0; b < 2; ++b)
#pragma unroll
                for (int m = 0; m < 4; ++m)
#pragma unroll
                    for (int n = 0; n < 2; ++n) acc[a][b][m][n] = (f32x4){0.f, 0.f, 0.f, 0.f};
        cur = nxt; cA = nA; cB = nB; ++ui;
        if (wr == 1) PG8_BAR;
    }
    PG8_WAIT_V(0);
    PG8_BAR;
#undef PG8_SA
#undef PG8_SB
#undef PG8_STAGE
#undef PG8_LDA
#undef PG8_LDB
#undef PG8_MMA
#undef PG8_WAIT_V
#undef PG8_WAIT_L
#undef PG8_BAR
#undef PG8_SCHED
}

#define FOR_AI_M _Pragma("unroll") for (int ai = 0; ai < 2; ++ai) _Pragma("unroll") for (int m = 0; m < 4; ++m)
#define FOR_BJ _Pragma("unroll") for (int bj = 0; bj < 2; ++bj)

struct EpiP1 {
    static constexpr bool MIDK = false;
    LAS float* X;
    bf16_t *QB, *KA, *VA, *BB, *CB, *UB, *MK, *MV;
    float *pk, *pv, *sk, *sv, *pmk, *pmv;
    const float *gq, *gk, *gxk; float c2;
    __device__ __forceinline__ void operator()(f32x4 (&acc)[2][2][4][2], const Unit& u, int wr, int wc, int fr, int fq) const {
        int hw = 0, kind = 0; const float* gain = nullptr; float sc = 1.f; bf16_t* ob; float* fp = nullptr; float* fs = nullptr;
        const int cb = (u.pn & 3) * 256;
        if (u.gid == 0) { const int seg = u.pn >> 2;
            if (seg == 0) { hw = 128; gain = gq; sc = c2; ob = QB; }
            else if (seg == 1) { hw = 128; gain = gk; ob = KA; fp = pk; fs = sk; kind = 1; }
            else if (seg == 2) { ob = VA; fp = pv; fs = sv; kind = 1; }
            else if (seg == 3) ob = BB; else { ob = CB; kind = 3; }
        } else { kind = 2; if (u.pn < 4) { hw = 256; gain = gxk; ob = MK; fp = pmk; } else { ob = MV; fp = pmv; } }
        float tot[2][4][2];
        if (hw) head_ss(acc, tot, X, wr, wc, fr, fq);
        f32x4 gv[2][2];
        FOR_BJ
#pragma unroll
            for (int n = 0; n < 2; ++n) gv[bj][n] = gain ? *(const f32x4*)(gain + (hw == 256 ? 128 * bj : 0) + 32 * wc + 8 * fq + 4 * n) : (f32x4){1.f, 1.f, 1.f, 1.f};
        FOR_AI_M {
            const int grow = u.pm * BM + ai * HALF + wr * 64 + m * 16 + fr;
            size_t brow = (size_t)grow; long frow = -1; float* fb = nullptr;
            if (kind == 2) { frow = grow; fb = fp; }
            else if (kind == 1) {
                if (grow < NPR) { const int t = grow & (SEQ - 1); if (t >= SEQ - 512) { frow = (long)(grow >> 13) * 512 + t - (SEQ - 512); fb = fp; } }
                else { const int s = grow - NPR, b = s >> 6, t = s & 63; brow = (size_t)NPR + (size_t)b * 576 + 512 + t; frow = (long)b * 512 + 448 + t; fb = fs; }
            }
            FOR_BJ {
                float sl = 1.f;
                if (hw) { const float t = (hw == 128) ? tot[ai][m][bj] : tot[ai][m][0] + tot[ai][m][1]; sl = rsqrtf(t / (float)hw + EPS) * sc; }
                const f32x4 v0 = acc[ai][bj][m][0] * sl * gv[bj][0], v1 = acc[ai][bj][m][1] * sl * gv[bj][1];
                const int col = cb + 128 * bj + 32 * wc + 8 * fq;
                if (kind == 3) {
                    if (bj == 0) *(u32x4*)(CB + brow * 1024 + (u.pn - 16) * 128 + 32 * wc + 8 * fq) = pack8(acc[ai][0][m][0] * acc[ai][1][m][0], acc[ai][0][m][1] * acc[ai][1][m][1]);
                    continue; }
                *(u32x4*)(ob + brow * 1024 + col) = pack8(v0, v1);
                if (fb) { *(f32x4*)(fb + (size_t)frow * 1024 + col) = v0; *(f32x4*)(fb + (size_t)frow * 1024 + col + 4) = v1; }
            }
            asm volatile("" ::: "memory");
        }
    }
};

struct EpiP3 {
    static constexpr bool MIDK = false;
    LAS float* X; const float *xp, *xs; bf16_t* HB; float* SS2;
    __device__ __forceinline__ void operator()(f32x4 (&acc)[2][2][4][2], const Unit& u, int wr, int wc, int fr, int fq) const {
        const float* xb = u.pm < NPR / BM ? xp : xs - (size_t)NPR * DM;
#pragma unroll
        for (int ai = 0; ai < 2; ++ai) {
            f32x4 xr[4][2][2];
#pragma unroll
            for (int m = 0; m < 4; ++m) FOR_BJ { const unsigned off = (unsigned)(u.pm * BM + ai * HALF + wr * 64 + m * 16 + fr) * DM + u.pn * BM + 128 * bj + 32 * wc + 8 * fq;
                xr[m][bj][0] = *(const f32x4*)(xb + off); xr[m][bj][1] = *(const f32x4*)(xb + off + 4); }
#pragma unroll
            for (int m = 0; m < 4; ++m) FOR_BJ { const unsigned off = (unsigned)(u.pm * BM + ai * HALF + wr * 64 + m * 16 + fr) * DM + u.pn * BM + 128 * bj + 32 * wc + 8 * fq;
                const f32x4 v0 = acc[ai][bj][m][0] + xr[m][bj][0], v1 = acc[ai][bj][m][1] + xr[m][bj][1];
                acc[ai][bj][m][0] = v0; acc[ai][bj][m][1] = v1;
                *(u32x4*)(HB + off) = pack8(v0, v1); }
            asm volatile("" ::: "memory");
        }
        float tot[2][4][2]; head_ss(acc, tot, X, wr, wc, fr, fq);
        if (wc == 0 && fq == 0) { FOR_AI_M { const int grow = u.pm * BM + ai * HALF + wr * 64 + m * 16 + fr; SS2[(size_t)grow * 8 + u.pn] = tot[ai][m][0] + tot[ai][m][1]; } }
    }
};

struct EpiP4 {
    static constexpr bool MIDK = false;
    LAS float* X; const float* SS2; const float* gxq; bf16_t* QX; float c2x;
    __device__ __forceinline__ void operator()(f32x4 (&acc)[2][2][4][2], const Unit& u, int wr, int wc, int fr, int fq) const {
        FOR_AI_M { const int grow = u.pm * BM + ai * HALF + wr * 64 + m * 16 + fr;
            const f32x4 a0 = *(const f32x4*)(SS2 + (size_t)grow * 8), a1 = *(const f32x4*)(SS2 + (size_t)grow * 8 + 4);
            const float r2 = rsqrtf(((a0[0] + a0[1]) + (a0[2] + a0[3]) + (a1[0] + a1[1]) + (a1[2] + a1[3])) * (1.f / 2048.f) + EPS);
            FOR_BJ { acc[ai][bj][m][0] *= r2; acc[ai][bj][m][1] *= r2; } }
        float tot[2][4][2]; head_ss(acc, tot, X, wr, wc, fr, fq);
        f32x4 gv[2][2];
        FOR_BJ
#pragma unroll
            for (int n = 0; n < 2; ++n) gv[bj][n] = *(const f32x4*)(gxq + 128 * bj + 32 * wc + 8 * fq + 4 * n);
        FOR_AI_M { const int grow = u.pm * BM + ai * HALF + wr * 64 + m * 16 + fr;
            const float s = rsqrtf((tot[ai][m][0] + tot[ai][m][1]) * (1.f / 256.f) + EPS) * c2x;
            FOR_BJ { const int col = u.pn * BM + 128 * bj + 32 * wc + 8 * fq;
                *(u32x4*)(QX + (size_t)grow * 1024 + col) = pack8(acc[ai][bj][m][0] * s * gv[bj][0], acc[ai][bj][m][1] * s * gv[bj][1]); } }
    }
};

struct EpiP6 {
    static constexpr bool MIDK = false;
    LAS float* X; bf16_t* H2B; float* SS3;
    __device__ __forceinline__ void operator()(f32x4 (&acc)[2][2][4][2], const Unit& u, int wr, int wc, int fr, int fq) const {
#pragma unroll
        for (int ai = 0; ai < 2; ++ai) {
            u32x4 hr[4][2];
#pragma unroll
            for (int m = 0; m < 4; ++m) FOR_BJ { const unsigned off = (unsigned)(u.pm * BM + ai * HALF + wr * 64 + m * 16 + fr) * DM + u.pn * BM + 128 * bj + 32 * wc + 8 * fq; hr[m][bj] = *(const u32x4*)(H2B + off); }
#pragma unroll
            for (int m = 0; m < 4; ++m) FOR_BJ { const unsigned off = (unsigned)(u.pm * BM + ai * HALF + wr * 64 + m * 16 + fr) * DM + u.pn * BM + 128 * bj + 32 * wc + 8 * fq;
                const u32x4 h = hr[m][bj];
                const f32x4 v0 = acc[ai][bj][m][0] + (f32x4){bflo(h.x), bfhi(h.x), bflo(h.y), bfhi(h.y)}, v1 = acc[ai][bj][m][1] + (f32x4){bflo(h.z), bfhi(h.z), bflo(h.w), bfhi(h.w)};
                acc[ai][bj][m][0] = v0; acc[ai][bj][m][1] = v1;
                *(u32x4*)(H2B + off) = pack8(v0, v1); }
            asm volatile("" ::: "memory");
        }
        float tot[2][4][2]; head_ss(acc, tot, X, wr, wc, fr, fq);
        if (wc == 0 && fq == 0) { FOR_AI_M { const int grow = u.pm * BM + ai * HALF + wr * 64 + m * 16 + fr; SS3[(size_t)grow * 8 + u.pn] = tot[ai][m][0] + tot[ai][m][1]; } }
    }
};

__device__ __forceinline__ float dpp_ror1(float v) { return __builtin_bit_cast(float, __builtin_amdgcn_update_dpp(0, __builtin_bit_cast(int, v), 0x121, 0xf, 0xf, false)); }
__device__ __forceinline__ float dpp_ror2(float v) { return __builtin_bit_cast(float, __builtin_amdgcn_update_dpp(0, __builtin_bit_cast(int, v), 0x122, 0xf, 0xf, false)); }
__device__ __forceinline__ float silu_mul(float cv, float g) { return cv * __builtin_amdgcn_rcpf(1.f + __builtin_amdgcn_exp2f(-cv * LOG2E)) * g; }
struct EpiP7 {
    static constexpr bool MIDK = false;
    LAS float* XH; const float* SS3; bf16_t* ACT; float *pf, *sf; const float* cffn; const float* wf; float *TAIL, *HEADU, *HEADG;
    __device__ __forceinline__ void operator()(f32x4 (&acc)[2][2][4][2], const Unit& u, int wr, int wc, int fr, int fq) const {
        const int f0 = u.pn * 128 + 32 * wc + 8 * fq;
        const bool smp = u.pm >= NPR / BM;
        FOR_AI_M { const int grow = u.pm * BM + ai * HALF + wr * 64 + m * 16 + fr;
            const f32x4 a0 = *(const f32x4*)(SS3 + (size_t)grow * 8), a1 = *(const f32x4*)(SS3 + (size_t)grow * 8 + 4);
            const float r3 = rsqrtf(((a0[0] + a0[1]) + (a0[2] + a0[3]) + (a1[0] + a1[1]) + (a1[2] + a1[3])) * (1.f / 2048.f) + EPS);
            FOR_BJ { acc[ai][bj][m][0] *= r3; acc[ai][bj][m][1] *= r3; } }
        if (fr >= 14) {
#pragma unroll
            for (int ai = 0; ai < 2; ++ai) { LAS float* xp = XH + ((2 * ai + wr) * 2 + (fr - 14)) * 128 + 32 * wc + 8 * fq; *(LAS f32x4*)xp = acc[ai][0][3][0]; *(LAS f32x4*)(xp + 4) = acc[ai][0][3][1]; } }
        EPI_BAR();
        FOR_AI_M { const int grow = u.pm * BM + ai * HALF + wr * 64 + m * 16 + fr;
            float* fo = nullptr;
            if (!smp) { const int t = grow & (SEQ - 1); if (t >= SEQ - 2) fo = pf + ((size_t)(grow >> 13) * 2 + (t - (SEQ - 2))) * DFF; }
            else { const int s = grow - NPR, t = s & 63; if (t >= 62) fo = sf + ((size_t)(s >> 6) * 2 + (t - 62)) * DFF; }
            if (fo) { *(f32x4*)(fo + f0) = acc[ai][0][m][0]; *(f32x4*)(fo + f0 + 4) = acc[ai][0][m][1]; } }
        if (!smp) {
            if (wr == 1 && fr >= 14) { float* tp = TAIL + ((size_t)u.pm * 2 + (fr - 14)) * DFF + f0; *(f32x4*)tp = acc[1][0][3][0]; *(f32x4*)(tp + 4) = acc[1][0][3][1]; }
            if (wr == 0 && fr < 2) { float* hp = HEADU + ((size_t)u.pm * 2 + fr) * DFF + f0; *(f32x4*)hp = acc[0][0][0][0]; *(f32x4*)(hp + 4) = acc[0][0][0][1];
                                     float* gp = HEADG + ((size_t)u.pm * 2 + fr) * DFF + f0; *(f32x4*)gp = acc[0][1][0][0]; *(f32x4*)(gp + 4) = acc[0][1][0][1]; }
        }
        f32x4 w0[2], w1[2], w2[2];
#pragma unroll
        for (int n = 0; n < 2; ++n) { w0[n] = *(const f32x4*)(wf + f0 + 4 * n); w1[n] = *(const f32x4*)(wf + DFF + f0 + 4 * n); w2[n] = *(const f32x4*)(wf + 2 * DFF + f0 + 4 * n); }
#pragma unroll
        for (int ai = 0; ai < 2; ++ai) {
            const int blk = 2 * ai + wr;
            f32x4 pv[2];
            if (smp) { const int b = (u.pm * BM - NPR) / 64 + blk; const float* cp = cffn + ((size_t)b * 2 + (fr == 15 ? 1 : 0)) * DFF + f0; pv[0] = *(const f32x4*)cp; pv[1] = *(const f32x4*)(cp + 4); }
            else if (blk == 0) { pv[0] = (f32x4){0.f, 0.f, 0.f, 0.f}; pv[1] = pv[0]; }
            else { const LAS float* xp = XH + ((blk - 1) * 2 + (fr == 15 ? 1 : 0)) * 128 + 32 * wc + 8 * fq; pv[0] = *(const LAS f32x4*)xp; pv[1] = *(const LAS f32x4*)(xp + 4); }
#pragma unroll
            for (int m = 0; m < 4; ++m) {
                const int grow = u.pm * BM + ai * HALF + wr * 64 + m * 16 + fr;
                f32x4 av[2];
#pragma unroll
                for (int n = 0; n < 2; ++n)
#pragma unroll
                    for (int e = 0; e < 4; ++e) {
                        const float cur = acc[ai][0][m][n][e], prv = pv[n][e];
                        const float a1 = dpp_ror1(cur), b1 = dpp_ror1(prv), a2 = dpp_ror2(cur), b2 = dpp_ror2(prv);
                        const float p1 = fr >= 1 ? a1 : b1, p2 = fr >= 2 ? a2 : b2;
                        const float cv = w0[n][e] * p2 + w1[n][e] * p1 + w2[n][e] * cur;
                        av[n][e] = silu_mul(cv, acc[ai][1][m][n][e]);
                    }
                *(u32x4*)(ACT + (size_t)grow * DFF + f0) = pack8(av[0], av[1]);
                pv[0] = acc[ai][0][m][0]; pv[1] = acc[ai][0][m][1];
            }
        }
    }
};

struct EpiP9 {
    static constexpr bool MIDK = false;
    float* Y; const bf16_t* H2B; float* PART;
    __device__ __forceinline__ void operator()(f32x4 (&acc)[2][2][4][2], const Unit& u, int wr, int wc, int fr, int fq) const {
        if (u.ks >= 0) {
            float* pp = PART + (size_t)(u.tail * 4 + u.ks) * 65536;
            FOR_AI_M FOR_BJ { float* yp = pp + (ai * HALF + wr * 64 + m * 16 + fr) * 256 + 128 * bj + 32 * wc + 8 * fq; *(f32x4*)yp = acc[ai][bj][m][0]; *(f32x4*)(yp + 4) = acc[ai][bj][m][1]; }
            return;
        }
#pragma unroll
        for (int ai = 0; ai < 2; ++ai) {
            u32x4 hr[4][2];
#pragma unroll
            for (int m = 0; m < 4; ++m) FOR_BJ { const unsigned off = (unsigned)(u.pm * BM + ai * HALF + wr * 64 + m * 16 + fr) * DM + u.pn * BM + 128 * bj + 32 * wc + 8 * fq; hr[m][bj] = *(const u32x4*)(H2B + off); }
#pragma unroll
            for (int m = 0; m < 4; ++m) FOR_BJ { const unsigned off = (unsigned)(u.pm * BM + ai * HALF + wr * 64 + m * 16 + fr) * DM + u.pn * BM + 128 * bj + 32 * wc + 8 * fq;
                const u32x4 h = hr[m][bj];
                *(f32x4*)(Y + off) = acc[ai][bj][m][0] + (f32x4){bflo(h.x), bfhi(h.x), bflo(h.y), bfhi(h.y)};
                *(f32x4*)(Y + off + 4) = acc[ai][bj][m][1] + (f32x4){bflo(h.z), bfhi(h.z), bflo(h.w), bfhi(h.w)}; }
            asm volatile("" ::: "memory");
        }
    }
};

#define VTR8(r, A0, A1, A2, A3) asm volatile( \
    "ds_read_b64_tr_b16 %0, %8\n\tds_read_b64_tr_b16 %1, %9\n\tds_read_b64_tr_b16 %2, %8 offset:4096\n\tds_read_b64_tr_b16 %3, %9 offset:4096\n\t" \
    "ds_read_b64_tr_b16 %4, %10\n\tds_read_b64_tr_b16 %5, %11\n\tds_read_b64_tr_b16 %6, %10 offset:4096\n\tds_read_b64_tr_b16 %7, %11 offset:4096" \
    : "=&v"(r[0]), "=&v"(r[1]), "=&v"(r[2]), "=&v"(r[3]), "=&v"(r[4]), "=&v"(r[5]), "=&v"(r[6]), "=&v"(r[7]) : "v"(A0), "v"(A1), "v"(A2), "v"(A3) : "memory")
#define VTRW(n, r, x, y) asm volatile("s_waitcnt lgkmcnt(" #n ")" : "+v"(r[0]), "+v"(r[1]), "+v"(r[2]), "+v"(r[3]), "+v"(r[4]), "+v"(r[5]), "+v"(r[6]), "+v"(r[7]), "+v"(x), "+v"(y) :: "memory")
#define VFR2(lo, hi2) ((bf16x8){lo[0], lo[1], lo[2], lo[3], hi2[0], hi2[1], hi2[2], hi2[3]})
__device__ __forceinline__ s16x4 vtr(const LAS unsigned char* p) { typedef short v4i16 __attribute__((ext_vector_type(4))); return __builtin_bit_cast(s16x4, __builtin_amdgcn_ds_read_tr16_b64_v4i16((LAS v4i16*)p)); }

template <int NKI, int NS, bool BAND>
__device__ __forceinline__ void attn_unit(LAS unsigned char* lds, const bf16_t* Kg, const bf16_t* Vg, const int colbase, const int nsteps, const bf16_t* Qg, const int nq,
                                          bf16_t* Og, const int ldo, float* ssa, const int head0, const int crel0, const LAS float* btab, const float cinit) {
    const int tid = threadIdx.x, lane = tid & 63, w = __builtin_amdgcn_readfirstlane(tid >> 6), hi = lane >> 5, l31 = lane & 31;
    constexpr int TILE = 8192, NT = NS * 2 * NKI, STG = NT * TILE;
    const int s = BAND ? (w >> 1) : 0, qb = BAND ? (w & 1) : (w >> 1), dsel = BAND ? 0 : (w & 1);
    const int col0 = colbase + s * 128 * NKI;
    const bool active = qb * 32 < nq;
    const int drow = 4 * w + (lane >> 4), fdr = ((drow & 3) << 2) | ((drow >> 2) & 3);
    const size_t goff = (size_t)drow * 2048 + (size_t)(((lane & 15) ^ fdr) << 4);
#define ATT_ISSUE(j_, stg_) do { const char* kb_ = (const char*)Kg + (size_t)(j_) * 65536 + goff; const char* vb_ = (const char*)Vg + (size_t)(j_) * 65536 + goff; \
        LAS unsigned char* d_ = lds + (stg_) * STG + w * 1024; \
        _Pragma("unroll") for (int s_ = 0; s_ < NS; ++s_) _Pragma("unroll") for (int i_ = 0; i_ < NKI; ++i_) { \
            const int cc_ = (colbase + s_ * 128 * NKI + i_ * 128) * 2; \
            __builtin_amdgcn_global_load_lds((const unsigned*)(kb_ + cc_), (LAS unsigned*)(d_ + (s_ * 2 * NKI + i_) * TILE), 16, 0, 0); \
            __builtin_amdgcn_global_load_lds((const unsigned*)(vb_ + cc_), (LAS unsigned*)(d_ + (s_ * 2 * NKI + NKI + i_) * TILE), 16, 0, 0); } } while (0)
    ATT_ISSUE(0, 0);
    bf16x8 qf[8 * NKI];
    if (active) { const bf16_t* qp = Qg + (size_t)(qb * 32 + l31) * 1024 + col0 + 8 * hi;
#pragma unroll
        for (int i = 0; i < 8 * NKI; ++i) qf[i] = *(const bf16x8*)(qp + 16 * i); }
    else {
#pragma unroll
        for (int i = 0; i < 8 * NKI; ++i) qf[i] = (bf16x8){0, 0, 0, 0, 0, 0, 0, 0}; }
    const int fl = ((l31 & 3) << 2) | ((l31 >> 2) & 3);
    int koff[8];
#pragma unroll
    for (int s8 = 0; s8 < 8; ++s8) koff[s8] = 256 * l31 + (((2 * s8 + hi) ^ fl) << 4);
    const int q4 = (lane & 15) >> 2, blk = (lane >> 4) & 1, p4 = lane & 3;
    int voff[2][4];
#pragma unroll
    for (int t = 0; t < 2; ++t)
#pragma unroll
        for (int c = 0; c < 4; ++c) voff[t][c] = 256 * (4 * hi + 8 * t + q4) + ((((c ^ q4) << 2) | ((2 * blk + (p4 >> 1)) ^ ((hi + 2 * t) & 3))) << 4) + 8 * (p4 & 1);
    f32x16 o[4];
#pragma unroll
    for (int c = 0; c < 4; ++c)
#pragma unroll
        for (int r = 0; r < 16; ++r) o[c][r] = 0.f;
    float lsum = 0.f;
    const LAS float* tb = btab + (head0 + s) * 264;
    const float cfar = BAND ? tb[256] : cinit;
    asm volatile("s_waitcnt vmcnt(0) lgkmcnt(0)" ::: "memory"); __builtin_amdgcn_s_barrier(); asm volatile("" ::: "memory");
    for (int j = 0; j < nsteps; ++j) {
        if (j + 1 < nsteps) ATT_ISSUE(j + 1, (j + 1) & 1);
        if (active) {
            const LAS unsigned char* st = lds + (j & 1) * STG;
            const LAS unsigned char* Kt = st + (s * 2 * NKI) * TILE; const LAS unsigned char* Vt = st + (s * 2 * NKI + NKI + dsel) * TILE;
            f32x16 sc;
            bool nearb = false;
            if (BAND) { const int kcrel = crel0 - (j >> 1); nearb = kcrel < 3;
                if (nearb) { const int dbase = 64 * kcrel - 32 * (j & 1) + qb * 32 + l31 - 4 * hi;
#pragma unroll
                    for (int r = 0; r < 16; ++r) { int d = dbase - ((r & 3) + 8 * (r >> 2)); d = d > 128 ? 128 : d; sc[r] = tb[d + 128]; } } }
            if (!nearb) {
#pragma unroll
                for (int r = 0; r < 16; ++r) sc[r] = cfar; }
#pragma unroll
            for (int i = 0; i < NKI; ++i) {
                bf16x8 kf[8];
#pragma unroll
                for (int s8 = 0; s8 < 8; ++s8) kf[s8] = *(const LAS bf16x8*)(Kt + i * TILE + koff[s8]);
                asm volatile("s_waitcnt lgkmcnt(0)" : "+v"(kf[0]), "+v"(kf[1]), "+v"(kf[2]), "+v"(kf[3]), "+v"(kf[4]), "+v"(kf[5]), "+v"(kf[6]), "+v"(kf[7]) :: "memory");
#pragma unroll
                for (int s8 = 0; s8 < 8; ++s8) sc = __builtin_amdgcn_mfma_f32_32x32x16_bf16(kf[s8], qf[i * 8 + s8], sc, 0, 0, 0);
            }
            s16x4 va[8], vb[8];
            { const unsigned sb = (unsigned)(size_t)Vt; VTR8(va, sb + voff[0][0], sb + voff[1][0], sb + voff[0][1], sb + voff[1][1]); VTR8(vb, sb + voff[0][2], sb + voff[1][2], sb + voff[0][3], sb + voff[1][3]); }
            float pe[16];
#pragma unroll
            for (int r = 0; r < 16; ++r) { pe[r] = __builtin_amdgcn_exp2f(sc[r]); lsum += pe[r]; }
            u32x4 pw0, pw1;
            pw0.x = cvtpk(pe[0], pe[1]); pw0.y = cvtpk(pe[2], pe[3]); pw0.z = cvtpk(pe[4], pe[5]); pw0.w = cvtpk(pe[6], pe[7]);
            pw1.x = cvtpk(pe[8], pe[9]); pw1.y = cvtpk(pe[10], pe[11]); pw1.z = cvtpk(pe[12], pe[13]); pw1.w = cvtpk(pe[14], pe[15]);
            VTRW(8, va, pw0, pw1);
            const bf16x8 pa0 = __builtin_bit_cast(bf16x8, pw0), pa1 = __builtin_bit_cast(bf16x8, pw1);
            o[0] = __builtin_amdgcn_mfma_f32_32x32x16_bf16(pa0, VFR2(va[0], va[1]), o[0], 0, 0, 0); o[0] = __builtin_amdgcn_mfma_f32_32x32x16_bf16(pa1, VFR2(va[2], va[3]), o[0], 0, 0, 0);
            o[1] = __builtin_amdgcn_mfma_f32_32x32x16_bf16(pa0, VFR2(va[4], va[5]), o[1], 0, 0, 0); o[1] = __builtin_amdgcn_mfma_f32_32x32x16_bf16(pa1, VFR2(va[6], va[7]), o[1], 0, 0, 0);
            VTRW(0, vb, pw0, pw1);
            o[2] = __builtin_amdgcn_mfma_f32_32x32x16_bf16(pa0, VFR2(vb[0], vb[1]), o[2], 0, 0, 0); o[2] = __builtin_amdgcn_mfma_f32_32x32x16_bf16(pa1, VFR2(vb[2], vb[3]), o[2], 0, 0, 0);
            o[3] = __builtin_amdgcn_mfma_f32_32x32x16_bf16(pa0, VFR2(vb[4], vb[5]), o[3], 0, 0, 0); o[3] = __builtin_amdgcn_mfma_f32_32x32x16_bf16(pa1, VFR2(vb[6], vb[7]), o[3], 0, 0, 0);
        }
        asm volatile("s_waitcnt vmcnt(0) lgkmcnt(0)" ::: "memory"); __builtin_amdgcn_s_barrier(); asm volatile("" ::: "memory");
    }
#undef ATT_ISSUE
    LAS unsigned char* stg = lds + w * 8704;
    LAS float* lsc = (LAS float*)(lds + LSC_OFF) + w * 32;
    if (active) {
        const float l = lsum + __shfl_xor(lsum, 32);
        if (hi == 0) lsc[l31] = l;
        asm volatile("s_waitcnt lgkmcnt(0)" ::: "memory");
#pragma unroll
        for (int r = 0; r < 16; ++r) { const int q = (r & 3) + 8 * (r >> 2) + 4 * hi; const float rl = 1.f / lsc[q];
#pragma unroll
            for (int c = 0; c < 4; ++c) *(LAS bf16_t*)(stg + q * 272 + (32 * c + l31) * 2) = (bf16_t)f2bf(o[c][r] * rl); }
        asm volatile("s_waitcnt lgkmcnt(0)" ::: "memory");
        const int row = lane >> 1, half = lane & 1;
        bf16_t* op = Og + (size_t)(qb * 32 + row) * ldo + col0 + dsel * 128 + half * 64;
        float ss = 0.f;
#pragma unroll
        for (int i = 0; i < 8; ++i) { const u32x4 v = *(const LAS u32x4*)(stg + row * 272 + half * 128 + i * 16);
            ss += bflo(v.x) * bflo(v.x) + bfhi(v.x) * bfhi(v.x) + bflo(v.y) * bflo(v.y) + bfhi(v.y) * bfhi(v.y) + bflo(v.z) * bflo(v.z) + bfhi(v.z) * bfhi(v.z) + bflo(v.w) * bflo(v.w) + bfhi(v.w) * bfhi(v.w);
            *(u32x4*)(op + i * 8) = v; }
        if (BAND) { ss += __shfl_xor(ss, 1); if (half == 0) ssa[(size_t)(qb * 32 + row) * 8 + head0 + s] = ss; }
    }
    asm volatile("s_waitcnt lgkmcnt(0)" ::: "memory"); __builtin_amdgcn_s_barrier(); asm volatile("" ::: "memory");
}

template <int D>
__device__ __forceinline__ void band_unit(LAS unsigned char* lds, const bf16_t* Kg, const bf16_t* Vg, const int ntile, const bf16_t* Qg, bf16_t* Og, float* ssa, const int nci, const int crel0, const LAS float* tb) {
    const int tid = threadIdx.x, lane = tid & 63, w = __builtin_amdgcn_readfirstlane(tid >> 6), hi = lane >> 5, l31 = lane & 31;
    constexpr int STG = 16384;
    const int ci = w >> 1, qb = w & 1;
    const bool wact = ci < nci;
    const int drow = 4 * w + (lane >> 4), fdr = ((drow & 3) << 2) | ((drow >> 2) & 3);
    const size_t goff = (size_t)drow * 2048 + (size_t)(((lane & 15) ^ fdr) << 4);
#define BISSUE(j_) do { LAS unsigned char* d_ = lds + ((j_) & (D - 1)) * STG + w * 1024; \
        __builtin_amdgcn_global_load_lds((const unsigned*)((const char*)Kg + (size_t)(j_) * 65536 + goff), (LAS unsigned*)d_, 16, 0, 0); \
        __builtin_amdgcn_global_load_lds((const unsigned*)((const char*)Vg + (size_t)(j_) * 65536 + goff), (LAS unsigned*)(d_ + 8192), 16, 0, 0); } while (0)
    bf16x8 qf[8];
    if (wact) { const bf16_t* qp = Qg + (size_t)(64 * ci + 32 * qb + l31) * 1024 + 8 * hi;
#pragma unroll
        for (int i = 0; i < 8; ++i) qf[i] = *(const bf16x8*)(qp + 16 * i); }
    else {
#pragma unroll
        for (int i = 0; i < 8; ++i) qf[i] = (bf16x8){0, 0, 0, 0, 0, 0, 0, 0}; }
#pragma unroll
    for (int j = 0; j < 4; ++j) if (j < ntile) BISSUE(j);
    const int fl = ((l31 & 3) << 2) | ((l31 >> 2) & 3);
    int koff[8];
#pragma unroll
    for (int s8 = 0; s8 < 8; ++s8) koff[s8] = 256 * l31 + (((2 * s8 + hi) ^ fl) << 4);
    const int q4 = (lane & 15) >> 2, blk = (lane >> 4) & 1, p4 = lane & 3;
    int voff[2][4];
#pragma unroll
    for (int t = 0; t < 2; ++t)
#pragma unroll
        for (int c = 0; c < 4; ++c) voff[t][c] = 8192 + 256 * (4 * hi + 8 * t + q4) + ((((c ^ q4) << 2) | ((2 * blk + (p4 >> 1)) ^ ((hi + 2 * t) & 3))) << 4) + 8 * (p4 & 1);
    f32x16 o[4];
#pragma unroll
    for (int c = 0; c < 4; ++c)
#pragma unroll
        for (int r = 0; r < 16; ++r) o[c][r] = 0.f;
    float lsum = 0.f;
    const float cfar = tb[256];
    for (int j = 0; j < ntile; ++j) {
        if ((j & 3) == 0) {
            asm volatile("s_waitcnt vmcnt(0)" ::: "memory");
            __builtin_amdgcn_s_barrier(); asm volatile("" ::: "memory");
#pragma unroll
            for (int jj = 4; jj < 8; ++jj) if (j + jj < ntile) BISSUE(j + jj);
        }
        const int kcrel = crel0 + ci - (j >> 1);
        if (wact && kcrel >= 0 && kcrel <= 8) {
            const LAS unsigned char* st = lds + (j & (D - 1)) * STG;
            f32x16 sc;
            if (kcrel < 3) { const int dbase = 64 * kcrel - 32 * (j & 1) + qb * 32 + l31 - 4 * hi;
#pragma unroll
                for (int r = 0; r < 16; ++r) { int d = dbase - ((r & 3) + 8 * (r >> 2)); d = d > 128 ? 128 : d; sc[r] = tb[d + 128]; } }
            else {
#pragma unroll
                for (int r = 0; r < 16; ++r) sc[r] = cfar; }
            bf16x8 kf[8];
#pragma unroll
            for (int s8 = 0; s8 < 8; ++s8) kf[s8] = *(const LAS bf16x8*)(st + koff[s8]);
            asm volatile("s_waitcnt lgkmcnt(0)" : "+v"(kf[0]), "+v"(kf[1]), "+v"(kf[2]), "+v"(kf[3]), "+v"(kf[4]), "+v"(kf[5]), "+v"(kf[6]), "+v"(kf[7]) :: "memory");
#pragma unroll
            for (int s8 = 0; s8 < 8; ++s8) sc = __builtin_amdgcn_mfma_f32_32x32x16_bf16(kf[s8], qf[s8], sc, 0, 0, 0);
            s16x4 va[8], vb[8];
            { const unsigned sb = (unsigned)(size_t)st; VTR8(va, sb + voff[0][0], sb + voff[1][0], sb + voff[0][1], sb + voff[1][1]); VTR8(vb, sb + voff[0][2], sb + voff[1][2], sb + voff[0][3], sb + voff[1][3]); }
            float pe[16];
#pragma unroll
            for (int r = 0; r < 16; ++r) { pe[r] = __builtin_amdgcn_exp2f(sc[r]); lsum += pe[r]; }
            u32x4 pw0, pw1;
            pw0.x = cvtpk(pe[0], pe[1]); pw0.y = cvtpk(pe[2], pe[3]); pw0.z = cvtpk(pe[4], pe[5]); pw0.w = cvtpk(pe[6], pe[7]);
            pw1.x = cvtpk(pe[8], pe[9]); pw1.y = cvtpk(pe[10], pe[11]); pw1.z = cvtpk(pe[12], pe[13]); pw1.w = cvtpk(pe[14], pe[15]);
            VTRW(8, va, pw0, pw1);
            const bf16x8 pa0 = __builtin_bit_cast(bf16x8, pw0), pa1 = __builtin_bit_cast(bf16x8, pw1);
            o[0] = __builtin_amdgcn_mfma_f32_32x32x16_bf16(pa0, VFR2(va[0], va[1]), o[0], 0, 0, 0); o[0] = __builtin_amdgcn_mfma_f32_32x32x16_bf16(pa1, VFR2(va[2], va[3]), o[0], 0, 0, 0);
            o[1] = __builtin_amdgcn_mfma_f32_32x32x16_bf16(pa0, VFR2(va[4], va[5]), o[1], 0, 0, 0); o[1] = __builtin_amdgcn_mfma_f32_32x32x16_bf16(pa1, VFR2(va[6], va[7]), o[1], 0, 0, 0);
            VTRW(0, vb, pw0, pw1);
            o[2] = __builtin_amdgcn_mfma_f32_32x32x16_bf16(pa0, VFR2(vb[0], vb[1]), o[2], 0, 0, 0); o[2] = __builtin_amdgcn_mfma_f32_32x32x16_bf16(pa1, VFR2(vb[2], vb[3]), o[2], 0, 0, 0);
            o[3] = __builtin_amdgcn_mfma_f32_32x32x16_bf16(pa0, VFR2(vb[4], vb[5]), o[3], 0, 0, 0); o[3] = __builtin_amdgcn_mfma_f32_32x32x16_bf16(pa1, VFR2(vb[6], vb[7]), o[3], 0, 0, 0);
        }
    }
#undef BISSUE
    asm volatile("s_waitcnt vmcnt(0) lgkmcnt(0)" ::: "memory"); __builtin_amdgcn_s_barrier(); asm volatile("" ::: "memory");
    LAS unsigned char* stg = lds + w * 8704;
    LAS float* lsc = (LAS float*)(lds + LSC_OFF) + w * 32;
    if (wact) {
        const float l = lsum + __shfl_xor(lsum, 32);
        if (hi == 0) lsc[l31] = l;
        asm volatile("s_waitcnt lgkmcnt(0)" ::: "memory");
#pragma unroll
        for (int r = 0; r < 16; ++r) { const int q = (r & 3) + 8 * (r >> 2) + 4 * hi; const float rl = 1.f / lsc[q];
#pragma unroll
            for (int c = 0; c < 4; ++c) *(LAS bf16_t*)(stg + q * 272 + (32 * c + l31) * 2) = (bf16_t)f2bf(o[c][r] * rl); }
        asm volatile("s_waitcnt lgkmcnt(0)" ::: "memory");
        const int row = lane >> 1, half = lane & 1, orow = 64 * ci + 32 * qb + row;
        bf16_t* op = Og + (size_t)orow * DM + half * 64;
        float ss = 0.f;
#pragma unroll
        for (int i = 0; i < 8; ++i) { const u32x4 v = *(const LAS u32x4*)(stg + row * 272 + half * 128 + i * 16);
            ss += bflo(v.x) * bflo(v.x) + bfhi(v.x) * bfhi(v.x) + bflo(v.y) * bflo(v.y) + bfhi(v.y) * bfhi(v.y) + bflo(v.z) * bflo(v.z) + bfhi(v.z) * bfhi(v.z) + bflo(v.w) * bflo(v.w) + bfhi(v.w) * bfhi(v.w);
            *(u32x4*)(op + i * 8) = v; }
        ss += __shfl_xor(ss, 1); if (half == 0) ssa[(size_t)orow * 8] = ss;
    }
    asm volatile("s_waitcnt lgkmcnt(0)" ::: "memory"); __builtin_amdgcn_s_barrier(); asm volatile("" ::: "memory");
}

__device__ __forceinline__ void p0_transpose_item(const float* W, int K, int N, bf16_t* WT, int mode, const float* ga, const float* gb, int ksplit, LAS float* scr, int item, int lane) {
    const int nblk = N / 32, kb = item / nblk, nb = item % nblk, k0 = 64 * kb, n0 = 32 * nb;
    const float* g = ga ? (k0 < ksplit ? ga + k0 : gb + (k0 - ksplit)) : nullptr;
    f32x4 wv[8];
#pragma unroll
    for (int i = 0; i < 8; ++i) wv[i] = __builtin_nontemporal_load((const f32x4*)(W + (size_t)(k0 + 8 * i + (lane >> 3)) * N + n0 + 4 * (lane & 7)));
#pragma unroll
    for (int i = 0; i < 8; ++i) { const int kk = 8 * i + (lane >> 3); const float gg = g ? g[kk] : 1.f; LAS float* sp = scr + kk * 33 + 4 * (lane & 7);
        sp[0] = wv[i][0] * gg; sp[1] = wv[i][1] * gg; sp[2] = wv[i][2] * gg; sp[3] = wv[i][3] * gg; }
    asm volatile("s_waitcnt lgkmcnt(0)" ::: "memory");
    const int c = lane & 7;
#pragma unroll
    for (int j = 0; j < 4; ++j) { const int n = (lane >> 3) + 8 * j; const LAS float* sp = scr + (8 * c) * 33 + n;
        u32x4 o; o.x = cvtpk(sp[0 * 33], sp[1 * 33]); o.y = cvtpk(sp[2 * 33], sp[3 * 33]); o.z = cvtpk(sp[4 * 33], sp[5 * 33]); o.w = cvtpk(sp[6 * 33], sp[7 * 33]);
        const int nn = n0 + n; const int orow = mode == 0 ? nn : (mode == 3 ? (nn < 4096 ? nn : 4096 + (((nn - 4096) & 1023) >> 7) * 256 + (nn >= 5120 ? 128 : 0) + (nn & 127)) : ((nn >> 7) * 256 + (nn & 127) + (mode == 2 ? 128 : 0)));
        *(u32x4*)(WT + (size_t)orow * K + k0 + 8 * c) = o; }
    asm volatile("s_waitcnt lgkmcnt(0)" ::: "memory");
}
__device__ __forceinline__ void rms_row_to_bf16(const float* xrow, const float* g, bf16_t* orow, int lane) {
    const f32x4* xr = (const f32x4*)xrow + lane; const f32x4* gr = (const f32x4*)g + lane;
    f32x4 v[8]; float s = 0.f;
#pragma unroll
    for (int j = 0; j < 8; ++j) { v[j] = __builtin_nontemporal_load(xr + 64 * j); s += (v[j][0] * v[j][0] + v[j][1] * v[j][1]) + (v[j][2] * v[j][2] + v[j][3] * v[j][3]); }
    const float r = rsqrtf(wave_sum(s) * (1.f / 2048.f) + EPS);
    u32x2* o8 = (u32x2*)orow + lane;
#pragma unroll
    for (int j = 0; j < 8; ++j) { const f32x4 gg = gr[64 * j]; u32x2 o; o.x = cvtpk(v[j][0] * r * gg[0], v[j][1] * r * gg[1]); o.y = cvtpk(v[j][2] * r * gg[2], v[j][3] * r * gg[3]); o8[64 * j] = o; }
}
__device__ __forceinline__ void cvt_row_1024(const float* src, bf16_t* dst, float* fcopy, int lane) {
    const f32x4* xr = (const f32x4*)src + lane; u32x2* o8 = (u32x2*)dst + lane;
#pragma unroll
    for (int j = 0; j < 4; ++j) { const f32x4 v = xr[64 * j]; u32x2 o; o.x = cvtpk(v[0], v[1]); o.y = cvtpk(v[2], v[3]); o8[64 * j] = o; if (fcopy) ((f32x4*)fcopy + lane)[64 * j] = v; }
}

#define XB_TMO      128
#define XB_XCNT(j)  (256  + 64 * (j))
#define XB_XSUB(j)  (1280 + 64 * (j))
#define XB_XGEN(j)  (2304 + 64 * (j))
#define XB_TOP      3328
#define XB_TOPGEN   3392
#define XCD_BAR_WORDS 3456
#define XB_SPIN_CAP (1u << 20)
__device__ __forceinline__ unsigned xb_ld(unsigned* p)              { return __hip_atomic_load(p, __ATOMIC_RELAXED, __HIP_MEMORY_SCOPE_AGENT); }
__device__ __forceinline__ unsigned xb_add(unsigned* p, unsigned v) { return __hip_atomic_fetch_add(p, v, __ATOMIC_RELAXED, __HIP_MEMORY_SCOPE_AGENT); }
__device__ __forceinline__ unsigned xb_xcc_id() { return (unsigned)__builtin_amdgcn_s_getreg((3 << 11) | 20) & 0xFu; }
#define XB_SPIN(cond, bar) do { unsigned _sp = 0; while (cond) { __builtin_amdgcn_s_sleep(1); \
    if ((++_sp & 255u) == 0u) { if (xb_ld(&(bar)[XB_TMO])) break; if (_sp > XB_SPIN_CAP) { atomicAdd(&(bar)[XB_TMO], 1u); break; } } } } while (0)
struct XcdBarrier { unsigned* bar; unsigned x; volatile LAS unsigned* st; };
__device__ __forceinline__ XcdBarrier xcd_barrier_post(unsigned* bar, volatile LAS unsigned* st) {
    XcdBarrier b; b.bar = bar; b.x = xb_xcc_id(); b.st = st;
    if (threadIdx.x == 0) (void)xb_add(&bar[XB_XCNT(b.x)], 1u);
    return b;
}
__device__ __forceinline__ void xcd_barrier_complete(unsigned* bar, unsigned x, unsigned& nloc, unsigned& nx) {
    const unsigned G = gridDim.x * gridDim.y * gridDim.z;
    unsigned sum, cnt, mine, sp = 0u;
    for (;;) {
        sum = 0u; cnt = 0u; mine = 0u;
#pragma unroll
        for (unsigned j = 0; j < 16; ++j) { const unsigned c = xb_ld(&bar[XB_XCNT(j)]); sum += c; cnt += (c > 0u) ? 1u : 0u; mine = (j == x) ? c : mine; }
        if (sum == G) break;
        __builtin_amdgcn_s_sleep(1);
        if ((++sp & 255u) == 0u) { if (xb_ld(&bar[XB_TMO])) break; if (sp > XB_SPIN_CAP) { atomicAdd(&bar[XB_TMO], 1u); break; } }
    }
    nloc = mine > 0u ? mine : 1u; nx = cnt > 0u ? cnt : 1u;
}
__device__ __forceinline__ void xcd_barrier(const XcdBarrier& b) {
    asm volatile("s_waitcnt vmcnt(0)" ::: "memory");
    __syncthreads();
    if (threadIdx.x == 0) {
        unsigned* bar = b.bar;
        __builtin_amdgcn_s_waitcnt(0);
        unsigned nloc = b.st[0], nx = b.st[1];
        if (nloc == 0u) { xcd_barrier_complete(bar, b.x, nloc, nx); b.st[0] = nloc; b.st[1] = nx; }
        const unsigned old = xb_add(&bar[XB_XSUB(b.x)], 1u);
        const unsigned gen = old / nloc;
        if (old + 1u == (gen + 1u) * nloc) {
            __builtin_amdgcn_fence(__ATOMIC_RELEASE, "agent");
            asm volatile("s_waitcnt vmcnt(0)" ::: "memory");
            const unsigned og = xb_add(&bar[XB_TOP], 1u);
            const unsigned tg = og / nx;
            if (og + 1u == (tg + 1u) * nx) xb_add(&bar[XB_TOPGEN], 1u);
            else XB_SPIN(xb_ld(&bar[XB_TOPGEN]) == tg, bar);
            __builtin_amdgcn_fence(__ATOMIC_ACQUIRE, "agent");
            xb_add(&bar[XB_XGEN(b.x)], 1u);
            asm volatile("s_waitcnt vmcnt(0)" ::: "memory");
        } else {
            XB_SPIN(xb_ld(&bar[XB_XGEN(b.x)]) == gen, bar);
            __builtin_amdgcn_fence(__ATOMIC_ACQUIRE, "agent");
            asm volatile("s_waitcnt vmcnt(0)" ::: "memory");
        }
    }
    __syncthreads();
}

struct Args { const float* in[30]; float* out; unsigned char* ws; int ph_lo, ph_hi, li, pad; };

__global__ void __launch_bounds__(512, 2) fwd_kernel(Args a) {
    extern __shared__ __attribute__((aligned(16))) unsigned char lds_raw[];
    LAS unsigned char* lds = (LAS unsigned char*)lds_raw;
    cg::grid_group grid = cg::this_grid();
    const int tid = threadIdx.x, lane = tid & 63, wave = __builtin_amdgcn_readfirstlane(tid >> 6);
    const int G = gridDim.x, bid = blockIdx.x;
    const int gw = bid * 8 + wave, NGW = G * 8;
    unsigned char* ws = a.ws;
    const float *x_p = a.in[0], *x_s = a.in[1], *mem_p = a.in[2], *c_k = a.in[3], *c_v = a.in[4], *c_conv = a.in[5], *c_ffn = a.in[6], *c_mk = a.in[7], *c_mv = a.in[8];
    const float *g_norm1 = a.in[9], *w_in = a.in[10], *g_q = a.in[11], *g_k = a.in[12], *rel_bias = a.in[13], *w_cmix = a.in[14], *g_oa = a.in[15], *g_oc = a.in[16], *w_out = a.in[17];
    const float *g_norm2 = a.in[18], *g_memn = a.in[19], *w_xq = a.in[20], *w_xkv = a.in[21], *g_xq = a.in[22], *g_xk = a.in[23], *w_xo = a.in[24], *g_norm3 = a.in[25];
    const float *w_up = a.in[26], *w_gate = a.in[27], *w_fconv = a.in[28], *w_down = a.in[29];
    float* out = a.out;
    float* Y = out;
    float* o_pk = out + (size_t)MT * DM; float* o_pv = o_pk + 2097152; float* o_pc = o_pv + 2097152; float* o_pf = o_pc + 8192; float* o_pmk = o_pf + 45056; float* o_pmv = o_pmk + 1048576;
    float* o_sk = o_pmv + 1048576; float* o_sv = o_sk + 16777216; float* o_sc = o_sv + 16777216; float* o_sf = o_sc + 65536;
    float* SSA = (float*)(ws + WS_SSA); float* SSB = (float*)(ws + WS_SSB); float* SS2 = (float*)(ws + WS_SS2); float* SS3 = (float*)(ws + WS_SS3);
    bf16_t* WUG = (bf16_t*)(ws + WS_WUG); bf16_t* WDN = (bf16_t*)(ws + WS_WDN); bf16_t* WIN = (bf16_t*)(ws + WS_WIN); bf16_t* WOUT = (bf16_t*)(ws + WS_WOUT);
    bf16_t* WXQ = (bf16_t*)(ws + WS_WXQ); bf16_t* WXKV = (bf16_t*)(ws + WS_WXKV); bf16_t* WXO = (bf16_t*)(ws + WS_WXO);
    bf16_t* XN = (bf16_t*)(ws + WS_XN); bf16_t* HB = (bf16_t*)(ws + WS_HB); bf16_t* H2B = (bf16_t*)(ws + WS_H2B);
    bf16_t* QB = (bf16_t*)(ws + WS_QB); bf16_t* KA = (bf16_t*)(ws + WS_KA); bf16_t* VA = (bf16_t*)(ws + WS_VA); bf16_t* BBf = (bf16_t*)(ws + WS_BB); bf16_t* CBf = (bf16_t*)(ws + WS_CB); bf16_t* UBf = (bf16_t*)(ws + WS_UB);
    bf16_t* MIX = (bf16_t*)(ws + WS_MIX); bf16_t* QX = (bf16_t*)(ws + WS_QX); bf16_t* XO = (bf16_t*)(ws + WS_XO); bf16_t* UP = (bf16_t*)(ws + WS_UP); bf16_t* GATE = (bf16_t*)(ws + WS_GATE);
    float* TAILB = (float*)(ws + WS_TAIL); float* HEADU = (float*)(ws + WS_HEADU); float* HEADG = (float*)(ws + WS_HEADG);
    bf16_t* MEMN = (bf16_t*)(ws + WS_MEMN); bf16_t* MKA = (bf16_t*)(ws + WS_MKA); bf16_t* MVA = (bf16_t*)(ws + WS_MVA);
    LAS float* XCH = (LAS float*)(lds + XCH_OFF);
    const int lo = a.ph_lo, hi_ph = a.ph_hi;
#ifdef ONLY_PHASE
#define IN(k) ((k) == ONLY_PHASE && lo <= (k) && (k) < hi_ph)
#else
#define IN(k) (lo <= (k) && (k) < hi_ph)
#endif
#define SEAM(k) do { if (IN(k) && IN((k) + 1)) xcd_barrier(xbar); } while (0)
    if (a.ph_hi < 0) grid.sync();
    volatile LAS unsigned* MISC = (volatile LAS unsigned*)(lds + MISC_OFF);
    if (tid < 2) MISC[tid] = 0u;
    __syncthreads();
    XcdBarrier xbar = xcd_barrier_post((unsigned*)ws + a.li * XCD_BAR_WORDS, MISC);

    if (IN(0)) {
        LAS float* scr = (LAS float*)(lds + wave * 16384);
        constexpr int I_UP = 32 * 176, I_DN = 88 * 64, I_IN = 32 * 192, I_OUT = 32 * 64, I_XQ = 32 * 32, I_XKV = 32 * 64, I_XO = 16 * 64;
        constexpr int T0 = I_UP, T1 = T0 + I_UP, T2 = T1 + I_DN, T3 = T2 + I_IN, T4 = T3 + I_OUT, T5 = T4 + I_XQ, T6 = T5 + I_XKV, T7 = T6 + I_XO;
        for (int it = gw; it < T7; it += NGW) {
            if (it < T0) p0_transpose_item(w_up, DM, DFF, WUG, 1, g_norm3, g_norm3, 1 << 30, scr, it, lane);
            else if (it < T1) p0_transpose_item(w_gate, DM, DFF, WUG, 2, g_norm3, g_norm3, 1 << 30, scr, it - T0, lane);
            else if (it < T2) p0_transpose_item(w_down, DFF, DM, WDN, 0, nullptr, nullptr, 0, scr, it - T1, lane);
            else if (it < T3) p0_transpose_item(w_in, DM, 6144, WIN, 3, nullptr, nullptr, 0, scr, it - T2, lane);
            else if (it < T4) p0_transpose_item(w_out, DM, DM, WOUT, 0, g_oa, g_oc, 1024, scr, it - T3, lane);
            else if (it < T5) p0_transpose_item(w_xq, DM, 1024, WXQ, 0, g_norm2, g_norm2, 1 << 30, scr, it - T4, lane);
            else if (it < T6) p0_transpose_item(w_xkv, DM, DM, WXKV, 0, nullptr, nullptr, 0, scr, it - T5, lane);
            else p0_transpose_item(w_xo, 1024, DM, WXO, 0, nullptr, nullptr, 0, scr, it - T6, lane);
        }
        for (int r = gw; r < MT + 1024; r += NGW) {
            const float* src = r < NPR ? x_p + (size_t)r * DM : (r < MT ? x_s + (size_t)(r - NPR) * DM : mem_p + (size_t)(r - MT) * DM);
            rms_row_to_bf16(src, r < MT ? g_norm1 : g_memn, (r < MT ? XN : MEMN - (size_t)MT * DM) + (size_t)r * DM, lane);
        }
        for (int r4 = gw; r4 < (2 * 16384 + 2 * 8192) / 4; r4 += NGW) {
            f32x4 v[4][4]; bf16_t* dst[4]; float* fc[4];
#pragma unroll
            for (int q = 0; q < 4; ++q) { const int r = r4 * 4 + q; const float* src;
                if (r < 32768) { const int kv = r >> 14, rr = r & 16383, b = rr >> 9, j = rr & 511;
                    src = (kv ? c_v : c_k) + (size_t)rr * 1024; dst[q] = (kv ? VA : KA) + ((size_t)NPR + (size_t)b * 576 + j) * 1024;
                    fc[q] = j >= 64 ? (kv ? o_sv : o_sk) + ((size_t)b * 512 + j - 64) * 1024 : nullptr; }
                else { const int r2 = r - 32768, kv = r2 >> 13, rr = r2 & 8191; src = (kv ? c_mv : c_mk) + (size_t)rr * 1024; dst[q] = (kv ? MVA : MKA) + ((size_t)1024 + rr) * 1024; fc[q] = nullptr; }
#pragma unroll
                for (int j = 0; j < 4; ++j) v[q][j] = __builtin_nontemporal_load((const f32x4*)src + lane + 64 * j); }
#pragma unroll
            for (int q = 0; q < 4; ++q)
#pragma unroll
                for (int j = 0; j < 4; ++j) { u32x2 o; o.x = cvtpk(v[q][j][0], v[q][j][1]); o.y = cvtpk(v[q][j][2], v[q][j][3]); ((u32x2*)dst[q] + lane)[64 * j] = o; if (fc[q]) __builtin_nontemporal_store(v[q][j], (f32x4*)fc[q] + lane + 64 * j); }
        }
    }
    SEAM(0);

    if (IN(1)) {
        Order S; S.init(MT, 6144, G, bid, 1024, 8);
        EpiP1 E{XCH, QB, KA, VA, BBf, CBf, UBf, MKA, MVA, o_pk, o_pv, o_sk, o_sv, o_pmk, o_pmv, g_q, g_k, g_xk, 0.08838834764831845f * LOG2E};
        gemm_phase<EpiP1>(lds, XN, WIN, MEMN, WXKV, DM, S, E);
    }
    SEAM(1);

    if (IN(2)) {
        LAS float* btab = (LAS float*)(lds + BT_OFF);
        {
            const float gqm = wave_max(fmaxf(fabsf(g_q[lane]), fabsf(g_q[lane + 64]))), gkm = wave_max(fmaxf(fabsf(g_k[lane]), fabsf(g_k[lane + 64])));
            float tm = -1e30f; for (int j = lane; j < 257; j += 64) tm = fmaxf(tm, rel_bias[wave * 257 + j]);
            tm = wave_max(tm);
            const float Mh = 11.313708498984761f * gqm * gkm * 1.01f + tm;
            for (int j = lane; j < 257; j += 64) btab[wave * 264 + j] = (rel_bias[wave * 257 + j] - Mh) * LOG2E;
        }
        asm volatile("s_waitcnt lgkmcnt(0)" ::: "memory"); __builtin_amdgcn_s_barrier(); asm volatile("" ::: "memory");
        for (int un = bid; un < 1024 + 256; un += G) {
            if (un < 1024) { const int h = un & 7, bg = un >> 3, b = bg >> 5, c0 = (bg & 31) * 4, klo = c0 > 8 ? c0 - 8 : 0;
                const size_t krow0 = (size_t)b * SEQ + 64 * klo, qrow0 = (size_t)b * SEQ + 64 * c0;
                band_unit<8>(lds, KA + krow0 * 1024 + h * 128, VA + krow0 * 1024 + h * 128, 2 * (c0 + 4 - klo), QB + qrow0 * 1024 + h * 128, MIX + qrow0 * DM + h * 128, SSA + qrow0 * 8 + h, 4, c0 - klo, btab + h * 264); }
            else { const int su = un - 1024, h = su & 7, b = su >> 3;
                const size_t krow0 = (size_t)NPR + (size_t)b * 576, qrow0 = (size_t)NPR + 64 * b;
                band_unit<8>(lds, KA + krow0 * 1024 + h * 128, VA + krow0 * 1024 + h * 128, 18, QB + qrow0 * 1024 + h * 128, MIX + qrow0 * DM + h * 128, SSA + qrow0 * 8 + h, 1, 8, btab + h * 264); }
        }
    }
    SEAM(2);

    if (IN(3)) {
        const int gwx = ((G % 8 == 0) ? (bid % 8) * (G / 8) + bid / 8 : bid) * 8 + wave;
        for (int r = gwx; r < MT; r += NGW) {
            { const f32x4 a0 = *(const f32x4*)(SSA + (size_t)r * 8), a1 = *(const f32x4*)(SSA + (size_t)r * 8 + 4);
              const float ra = rsqrtf(((a0[0] + a0[1]) + (a0[2] + a0[3]) + (a1[0] + a1[1]) + (a1[2] + a1[3])) * (1.f / 1024.f) + EPS);
              bf16_t* mp = MIX + (size_t)r * DM + lane * 16;
              u32x4 m0 = *(const u32x4*)mp, m1 = *(const u32x4*)(mp + 8);
#pragma unroll
              for (int i = 0; i < 4; ++i) { m0[i] = cvtpk(bflo(m0[i]) * ra, bfhi(m0[i]) * ra); m1[i] = cvtpk(bflo(m1[i]) * ra, bfhi(m1[i]) * ra); }
              *(u32x4*)mp = m0; *(u32x4*)(mp + 8) = m1; }
            int t, b; const bool smp = r >= NPR;
            if (!smp) { t = r & (SEQ - 1); b = r >> 13; } else { t = (r - NPR) & 63; b = (r - NPR) >> 6; }
            const int ch = lane * 16;
            float cu0[16], cu1[16], cu2[16], bv[16];
            { const u32x4 c0 = *(const u32x4*)(CBf + (size_t)r * 1024 + ch), c1 = *(const u32x4*)(CBf + (size_t)r * 1024 + ch + 8);
              const u32x4 b0 = *(const u32x4*)(BBf + (size_t)r * 1024 + ch), b1 = *(const u32x4*)(BBf + (size_t)r * 1024 + ch + 8);
#pragma unroll
              for (int i = 0; i < 4; ++i) { cu0[2 * i] = bflo(c0[i]); cu0[2 * i + 1] = bfhi(c0[i]); cu0[8 + 2 * i] = bflo(c1[i]); cu0[8 + 2 * i + 1] = bfhi(c1[i]);
                  bv[2 * i] = bflo(b0[i]); bv[2 * i + 1] = bfhi(b0[i]); bv[8 + 2 * i] = bflo(b1[i]); bv[8 + 2 * i + 1] = bfhi(b1[i]); } }
#pragma unroll
            for (int k = 1; k <= 2; ++k) {
                float* d = k == 1 ? cu1 : cu2;
                if (t - k >= 0) { const size_t rr = (size_t)(r - k) * 1024 + ch;
                    const u32x4 c0 = *(const u32x4*)(CBf + rr), c1 = *(const u32x4*)(CBf + rr + 8);
#pragma unroll
                    for (int i = 0; i < 4; ++i) { d[2 * i] = bflo(c0[i]); d[2 * i + 1] = bfhi(c0[i]); d[8 + 2 * i] = bflo(c1[i]); d[8 + 2 * i + 1] = bfhi(c1[i]); } }
                else if (smp) { const float* cp = c_conv + ((size_t)b * 2 + (2 + t - k)) * 1024 + ch;
#pragma unroll
                    for (int i = 0; i < 16; ++i) d[i] = cp[i]; }
                else {
#pragma unroll
                    for (int i = 0; i < 16; ++i) d[i] = 0.f; }
            }
            float ss = 0.f; unsigned ow[8];
#pragma unroll
            for (int cc = 0; cc < 16; ++cc) { const float cv = w_cmix[ch + cc] * cu2[cc] + w_cmix[1024 + ch + cc] * cu1[cc] + w_cmix[2048 + ch + cc] * cu0[cc]; bv[cc] *= cv; ss += bv[cc] * bv[cc]; }
            const float rbn = rsqrtf(wave_sum(ss) * (1.f / 1024.f) + EPS);
#pragma unroll
            for (int i = 0; i < 8; ++i) ow[i] = cvtpk(bv[2 * i] * rbn, bv[2 * i + 1] * rbn);
            *(u32x4*)(MIX + (size_t)r * DM + 1024 + ch) = (u32x4){ow[0], ow[1], ow[2], ow[3]}; *(u32x4*)(MIX + (size_t)r * DM + 1024 + ch + 8) = (u32x4){ow[4], ow[5], ow[6], ow[7]};
            float* cvo = nullptr;
            if (!smp) { if (t >= SEQ - 2) cvo = o_pc + ((size_t)b * 2 + (t - (SEQ - 2))) * 1024; } else if (t >= 62) cvo = o_sc + ((size_t)b * 2 + (t - 62)) * 1024;
            if (cvo) {
#pragma unroll
                for (int i = 0; i < 4; ++i) *(f32x4*)(cvo + ch + 4 * i) = (f32x4){cu0[4 * i], cu0[4 * i + 1], cu0[4 * i + 2], cu0[4 * i + 3]}; }
        }
    }
    SEAM(3);

    if (IN(4)) {
        Order S; S.init(MT, DM, G, bid);
        EpiP3 E{XCH, x_p, x_s, HB, SS2};
        gemm_phase<EpiP3>(lds, MIX, WOUT, MIX, WOUT, DM, S, E);
    }
    SEAM(4);

    if (IN(5)) {
        Order S; S.init(MT, 1024, G, bid);
        EpiP4 E{XCH, SS2, g_xq, QX, 0.0625f * LOG2E};
        gemm_phase<EpiP4>(lds, HB, WXQ, HB, WXQ, DM, S, E);
    }
    SEAM(5);

    if (IN(6)) {
        float gm1 = fmaxf(fmaxf(fabsf(g_xq[lane]), fabsf(g_xq[lane + 64])), fmaxf(fabsf(g_xq[lane + 128]), fabsf(g_xq[lane + 192])));
        float gm2 = fmaxf(fmaxf(fabsf(g_xk[lane]), fabsf(g_xk[lane + 64])), fmaxf(fabsf(g_xk[lane + 128]), fabsf(g_xk[lane + 192])));
        const float cinit = -(16.f * wave_max(gm1) * wave_max(gm2) * 1.01f) * LOG2E;
        for (int un = bid; un < 1024 + 128; un += G) {
            size_t krow0, qrow0; int h, nq;
            if (un < 1024) { const int qt = un >> 2; h = un & 3; krow0 = (size_t)(qt >> 6) * 256; qrow0 = (size_t)qt * 128; nq = 128; }
            else { const int su = un - 1024, b = su >> 2; h = su & 3; krow0 = (size_t)(4 + b) * 256; qrow0 = (size_t)NPR + 64 * b; nq = 64; }
            attn_unit<2, 1, false>(lds, MKA + krow0 * 1024, MVA + krow0 * 1024, h * 256, 8, QX + qrow0 * 1024, nq, XO + qrow0 * 1024, 1024, nullptr, 0, 0, (const LAS float*)(lds + BT_OFF), cinit);
        }
    }
    SEAM(6);

    if (IN(7)) {
        Order S; S.init(MT, DM, G, bid);
        EpiP6 E{XCH, H2B, SS3};
        gemm_phase<EpiP6>(lds, XO, WXO, XO, WXO, 1024, S, E);
    }
    SEAM(7);

    if (IN(8)) {
        Order S; S.init(MT, 2 * DFF, G, bid);
        EpiP7 E{XCH, SS3, GATE, o_pf, o_sf, c_ffn, w_fconv, TAILB, HEADU, HEADG};
        gemm_phase<EpiP7>(lds, H2B, WUG, H2B, WUG, DM, S, E);
    }
    SEAM(8);

    if (IN(9)) {
        for (int it = gw; it < 128 * 11; it += NGW) {
            const int pm = it / 11, sl = it % 11, f = sl * 512 + lane * 8;
            if ((pm & 31) == 0) continue;
            const float* t0 = TAILB + ((size_t)(pm - 1) * 2) * DFF + f; const float* hu = HEADU + ((size_t)pm * 2) * DFF + f; const float* hg = HEADG + ((size_t)pm * 2) * DFF + f;
            float a0[8], a1[8];
#pragma unroll
            for (int i = 0; i < 8; ++i) { const float x2 = t0[i], x1 = t0[DFF + i], c0 = hu[i], c1 = hu[DFF + i];
                const float w0 = w_fconv[f + i], w1 = w_fconv[DFF + f + i], w2 = w_fconv[2 * DFF + f + i];
                a0[i] = silu_mul(w0 * x2 + w1 * x1 + w2 * c0, hg[i]); a1[i] = silu_mul(w0 * x1 + w1 * c0 + w2 * c1, hg[DFF + i]); }
            *(u32x4*)(GATE + (size_t)pm * BM * DFF + f) = (u32x4){cvtpk(a0[0], a0[1]), cvtpk(a0[2], a0[3]), cvtpk(a0[4], a0[5]), cvtpk(a0[6], a0[7])};
            *(u32x4*)(GATE + ((size_t)pm * BM + 1) * DFF + f) = (u32x4){cvtpk(a1[0], a1[1]), cvtpk(a1[2], a1[3]), cvtpk(a1[4], a1[5]), cvtpk(a1[6], a1[7])};
        }
    }
    SEAM(9);

    if (IN(10)) {
        Order S; S.init(MT, DM, G, bid, 0, 1, 1024, 4);
        EpiP9 E{Y, H2B, (float*)(ws + WS_UP)};
        gemm_phase<EpiP9>(lds, GATE, WDN, GATE, WDN, DFF, S, E);
    }
    SEAM(10);

    if (IN(11)) {
        Order S; S.init(MT, DM, G, bid, 0, 1, 1024, 4);
        const float* PART = (const float*)(ws + WS_UP);
        for (int wi = gw; wi < 64 * 256; wi += NGW) { const int tl = wi >> 8, row = wi & 255; int pm, pn; S.map(1024 + tl, pm, pn);
            const unsigned off = (unsigned)(pm * BM + row) * DM + pn * BM + lane * 4;
            const u32x2 h = *(const u32x2*)(H2B + off);
            const float* pp = PART + (size_t)tl * 4 * 65536 + row * 256 + lane * 4;
            const f32x4 p0 = *(const f32x4*)pp, p1 = *(const f32x4*)(pp + 65536), p2 = *(const f32x4*)(pp + 2 * 65536), p3 = *(const f32x4*)(pp + 3 * 65536);
            *(f32x4*)(Y + off) = (f32x4){bflo(h.x), bfhi(h.x), bflo(h.y), bfhi(h.y)} + ((p0 + p1) + (p2 + p3)); }
    }
#undef IN
#undef SEAM
}

extern "C" void kernel_launch(void* const* d_in, const int* in_sizes, int n_in, void* d_out, int out_size, void* d_ws, size_t ws_size, hipStream_t stream) {
    static int grid = 0;
    if (grid == 0) {
        int dev = 0, cus = 0, per_cu = 0;
        if (n_in != 30 || ws_size < WS_END) { fprintf(stderr, "kernel_launch: unexpected n_in %d or ws %zu\n", n_in, ws_size); grid = -1; return; }
        (void)hipGetDevice(&dev);
        (void)hipDeviceGetAttribute(&cus, hipDeviceAttributeMultiprocessorCount, dev);
        (void)hipFuncSetAttribute((const void*)fwd_kernel, hipFuncAttributeMaxDynamicSharedMemorySize, LDS_BYTES);
        (void)hipOccupancyMaxActiveBlocksPerMultiprocessor(&per_cu, (const void*)fwd_kernel, 512, LDS_BYTES);
        if (per_cu < 1) per_cu = 1;
        grid = cus * per_cu;
    }
    if (grid < 0) return;
    (void)hipMemsetAsync(d_ws, 0, 65536, stream);
    Args a{};
    for (int i = 0; i < 30; ++i) a.in[i] = (const float*)d_in[i];
    a.out = (float*)d_out; a.ws = (unsigned char*)d_ws; a.ph_lo = 0; a.ph_hi = 12;
    void* args[] = {&a};
#ifdef PROBE_PH
    a.ph_hi = PROBE_PH + 1;
    (void)hipLaunchCooperativeKernel((const void*)fwd_kernel, dim3(grid), dim3(512), args, LDS_BYTES, stream);
    for (int r = 0; r < PROBE_N; ++r) { a.ph_lo = PROBE_PH; a.ph_hi = PROBE_PH + 1; a.li = 1 + r; (void)hipLaunchCooperativeKernel((const void*)fwd_kernel, dim3(grid), dim3(512), args, LDS_BYTES, stream); }
    a.ph_lo = PROBE_PH + 1; a.ph_hi = 12; a.li = 1 + PROBE_N;
#endif
    hipError_t e = hipLaunchCooperativeKernel((const void*)fwd_kernel, dim3(grid), dim3(512), args, LDS_BYTES, stream);
    if (e != hipSuccess) fprintf(stderr, "cooperative launch failed: %s (grid %d)\n", hipGetErrorString(e), grid);
}
```

```cpp
#include <hip/hip_runtime.h>
#include <hip/hip_cooperative_groups.h>
#include <cstdio>
#include <cstdint>
namespace cg = cooperative_groups;

#define LAS __attribute__((address_space(3)))
typedef unsigned short bf16_t;
typedef short bf16x8 __attribute__((ext_vector_type(8)));
typedef short s16x4 __attribute__((ext_vector_type(4)));
typedef float f32x4 __attribute__((ext_vector_type(4)));
typedef float f32x2 __attribute__((ext_vector_type(2)));
typedef float f32x16 __attribute__((ext_vector_type(16)));
typedef unsigned u32x4 __attribute__((ext_vector_type(4)));
typedef unsigned u32x2 __attribute__((ext_vector_type(2)));
typedef __bf16 bf16x2_t __attribute__((ext_vector_type(2)));

constexpr int DM = 2048, NPR = 32768, MT = 34816, DFF = 5632, SEQ = 8192;
constexpr float EPS = 1e-6f, LOG2E = 1.4426950408889634f;
constexpr int KROWS = NPR + 32 * 576;

constexpr size_t MiB = 1u << 20;
constexpr size_t WS_SSA = 1 * MiB, WS_SSB = 3 * MiB, WS_SS2 = 4 * MiB, WS_SS3 = 6 * MiB;
constexpr size_t WS_WUG = 16 * MiB, WS_WDN = 60 * MiB;
constexpr size_t WS_XN = 82 * MiB, WS_HB = 82 * MiB, WS_H2B = 82 * MiB;
constexpr size_t WS_QB = 218 * MiB, WS_KA = 286 * MiB, WS_VA = 386 * MiB, WS_BB = 486 * MiB, WS_CB = 554 * MiB, WS_UB = 622 * MiB;
constexpr size_t WS_MIX = 698 * MiB;
constexpr size_t WS_QX = 218 * MiB, WS_XO = 286 * MiB;
constexpr size_t WS_UP = 218 * MiB, WS_GATE = 592 * MiB;
constexpr size_t WS_TAIL = 966 * MiB, WS_HEADU = 974 * MiB, WS_HEADG = 982 * MiB;
constexpr size_t WS_MEMN = 926 * MiB, WS_MKA = 930 * MiB, WS_MVA = 948 * MiB;
constexpr size_t WS_WIN = 966 * MiB, WS_WOUT = 990 * MiB, WS_WXQ = 998 * MiB, WS_WXKV = 1002 * MiB, WS_WXO = 1010 * MiB, WS_END = 1014 * MiB;

constexpr int RING_BYTES = 131072, XCH_OFF = 131072, BT_OFF = XCH_OFF + 8192, LSC_OFF = BT_OFF + 8 * 264 * 4, MISC_OFF = LSC_OFF + 8 * 32 * 4, LDS_BYTES = 153600;
static_assert(MISC_OFF + 64 <= LDS_BYTES, "lds map");

__device__ __forceinline__ unsigned cvtpk(float lo, float hi) { f32x2 v = {lo, hi}; bf16x2_t b = __builtin_convertvector(v, bf16x2_t); return __builtin_bit_cast(unsigned, b); }
__device__ __forceinline__ unsigned f2bf(float f) { unsigned u = __builtin_bit_cast(unsigned, f); return (u + 0x7fffu + ((u >> 16) & 1u)) >> 16; }
__device__ __forceinline__ float bflo(unsigned w) { return __builtin_bit_cast(float, w << 16); }
__device__ __forceinline__ float bfhi(unsigned w) { return __builtin_bit_cast(float, w & 0xffff0000u); }
__device__ __forceinline__ float wave_sum(float v) {
#pragma unroll
    for (int o = 1; o < 64; o <<= 1) v += __shfl_xor(v, o);
    return v;
}
__device__ __forceinline__ float wave_max(float v) {
#pragma unroll
    for (int o = 1; o < 64; o <<= 1) v = fmaxf(v, __shfl_xor(v, o));
    return v;
}
__device__ __forceinline__ u32x4 pack8(f32x4 a, f32x4 b) { u32x4 w; w.x = cvtpk(a[0], a[1]); w.y = cvtpk(a[2], a[3]); w.z = cvtpk(b[0], b[1]); w.w = cvtpk(b[2], b[3]); return w; }

constexpr int BM = 256, BK = 64, HALF = 128, HTB = HALF * BK * 2, NXCD = 8, WGM = 4;
__device__ __forceinline__ int lds_byte(int r, int c) { const int st = (r >> 4) * 2 + (c >> 5), rr = r & 15, cc = c & 31, ob = rr * 64 + cc * 2; return st * 1024 + (ob ^ (((ob >> 9) & 1) << 5)); }
__device__ __forceinline__ void stage_rc(int b, int& R, int& C) { const int st = b / 1024, sb = b % 1024, swz = sb ^ (((sb >> 9) & 1) << 5); R = (st >> 1) * 16 + swz / 64; C = (st & 1) * 32 + (swz % 64) / 2; }
__device__ __forceinline__ int perm32(int rho) { const int n = rho >> 4, i = rho & 15; return 8 * (i >> 2) + 4 * n + (i & 3); }

struct Unit { int pm, pn, gid, ks, tail; };
struct Order {
    int nM, nN, nwg, G, c, nex, exN, nfull, nsplit;
    __device__ __forceinline__ void init(int M, int N, int G_, int c_, int exM = 0, int exN_ = 1, int nfull_ = -1, int nsplit_ = 1) { nM = M / BM; nN = N / BM; nwg = nM * nN; G = G_; c = c_; exN = exN_; nex = (exM / BM) * exN_;
        nfull = nfull_ < 0 ? nwg : nfull_; nsplit = nsplit_; }
    __device__ __forceinline__ void map(int wgid, int& pm, int& pn) const {
        { const int q = nwg / NXCD, r = nwg % NXCD, xcd = wgid % NXCD, off = wgid / NXCD; wgid = (xcd < r ? xcd * (q + 1) : r * (q + 1) + (xcd - r) * q) + off; }
        const int nig = WGM * nN, gidx = wgid / nig, fm = gidx * WGM, gsz = (nM - fm) < WGM ? (nM - fm) : WGM;
        pm = fm + ((wgid % nig) % gsz); pn = (wgid % nig) / gsz;
    }
    __device__ __forceinline__ bool next(int i, Unit& u) const {
        const int L = i * G + c, nmain = nfull + (nwg - nfull) * nsplit; const bool ok = L < nmain + nex; const bool ex = L >= nmain;
        const int e = ex ? L - nmain : 0;
        const bool sp = !ex && L >= nfull; const int es = sp ? L - nfull : 0;
        const int wgid = ex ? 0 : (sp ? nfull + es / nsplit : L);
        int pm0, pn0; map(wgid, pm0, pn0);
        u.pm = ex ? e / exN : pm0; u.pn = ex ? e % exN : pn0; u.gid = ex ? 1 : 0; u.ks = sp ? es % nsplit : -1; u.tail = sp ? es / nsplit : 0;
        return ok;
    }
};

#define EPI_BAR() do { asm volatile("s_waitcnt lgkmcnt(0)" ::: "memory"); __builtin_amdgcn_s_barrier(); asm volatile("" ::: "memory"); } while (0)

__device__ __forceinline__ void head_ss(const f32x4 (&v)[2][2][4][2], float (&tot)[2][4][2], LAS float* X, int wr, int wc, int fr, int fq) {
#pragma unroll
    for (int ai = 0; ai < 2; ++ai)
#pragma unroll
        for (int m = 0; m < 4; ++m)
#pragma unroll
            for (int bj = 0; bj < 2; ++bj) {
                const f32x4 a = v[ai][bj][m][0], b = v[ai][bj][m][1];
                float s = (a[0] * a[0] + a[1] * a[1]) + (a[2] * a[2] + a[3] * a[3]) + (b[0] * b[0] + b[1] * b[1]) + (b[2] * b[2] + b[3] * b[3]);
                s += __shfl_xor(s, 16); s += __shfl_xor(s, 32);
                if (fq == 0) X[((ai * 128 + wr * 64 + m * 16 + fr) * 2 + bj) * 4 + wc] = s;
            }
    EPI_BAR();
#pragma unroll
    for (int ai = 0; ai < 2; ++ai)
#pragma unroll
        for (int m = 0; m < 4; ++m)
#pragma unroll
            for (int bj = 0; bj < 2; ++bj) { const f32x4 t = *(const LAS f32x4*)(X + ((ai * 128 + wr * 64 + m * 16 + fr) * 2 + bj) * 4); tot[ai][m][bj] = (t[0] + t[1]) + (t[2] + t[3]); }
}

template <class Epi>
__device__ __forceinline__ void gemm_phase(LAS unsigned char* lds, const bf16_t* A0, const bf16_t* B0, const bf16_t* A1, const bf16_t* B1, const int K, const Order& S, const Epi& E) {
    const int tid = threadIdx.x, wid = __builtin_amdgcn_readfirstlane(tid >> 6), lane = tid & 63, wr = wid >> 2, wc = wid & 3, fr = lane & 15, fq = lane >> 4;
    const int nt = K / BK;
    unsigned voffA[2], voffB[2];
#pragma unroll
    for (int i = 0; i < 2; ++i) { int R, C; stage_rc(tid * 16 + i * 8192, R, C); const int Rb = (R & ~31) + perm32(R & 31);
        voffA[i] = (unsigned)(R * K + C) * 2u; voffB[i] = (unsigned)(Rb * K + C) * 2u; }
    const size_t kstep = (size_t)(BK * 2);
    const size_t hstep = (size_t)HALF * K * 2;
    const size_t tstep = 2 * hstep;
    const unsigned ldsw = (unsigned)wid * 1024u;
    const int aoff = lds_byte(wr * 64 + fr, fq * 8), boff = lds_byte(wc * 32 + fr, fq * 8);
#define PG8_SA(b, h) (((b) * 2 + (h)) * HTB)
#define PG8_SB(b, h) ((4 + (b) * 2 + (h)) * HTB)
#define PG8_STAGE(bufoff, gbase, voff) do { _Pragma("unroll") for (int _i = 0; _i < 2; ++_i) \
        __builtin_amdgcn_global_load_lds((const unsigned*)((const char*)(gbase) + (voff)[_i]), (LAS unsigned*)(lds + (bufoff) + ldsw + _i * 8192), 16, 0, 0); } while (0)
#define PG8_LDA(dst, b, h) do { _Pragma("unroll") for (int m = 0; m < 4; ++m) _Pragma("unroll") for (int k = 0; k < 2; ++k) dst[m][k] = *(const LAS bf16x8*)(lds + PG8_SA(b, h) + aoff + m * 2048 + k * 1024); } while (0)
#define PG8_LDB(dst, b, h) do { _Pragma("unroll") for (int n = 0; n < 2; ++n) _Pragma("unroll") for (int k = 0; k < 2; ++k) dst[n][k] = *(const LAS bf16x8*)(lds + PG8_SB(b, h) + boff + n * 2048 + k * 1024); } while (0)
#define PG8_MMA(ai, bj, At, Bt) do { __builtin_amdgcn_s_setprio(1); _Pragma("unroll") for (int m = 0; m < 4; ++m) _Pragma("unroll") for (int n = 0; n < 2; ++n) _Pragma("unroll") for (int k = 0; k < 2; ++k) \
        acc[ai][bj][m][n] = __builtin_amdgcn_mfma_f32_16x16x32_bf16(Bt[n][k], At[m][k], acc[ai][bj][m][n], 0, 0, 0); __builtin_amdgcn_s_setprio(0); } while (0)
#define PG8_WAIT_V(n) asm volatile("s_waitcnt vmcnt(" #n ")" ::: "memory")
#define PG8_WAIT_L(n) asm volatile("s_waitcnt lgkmcnt(" #n ")" ::: "memory")
#define PG8_BAR __builtin_amdgcn_s_barrier()
#define PG8_SCHED __builtin_amdgcn_sched_barrier(0)
    Unit cur, nxt; int ui = 0;
    if (!S.next(0, cur)) return;
    f32x4 acc[2][2][4][2];
#pragma unroll
    for (int a = 0; a < 2; ++a)
#pragma unroll
        for (int b = 0; b < 2; ++b)
#pragma unroll
            for (int m = 0; m < 4; ++m)
#pragma unroll
                for (int n = 0; n < 2; ++n) acc[a][b][m][n] = (f32x4){0.f, 0.f, 0.f, 0.f};
    bf16x8 At[4][2], Bf0[2][2], Bf1[2][2];
    const int ntq = nt / S.nsplit;
    const char* cA = (const char*)(cur.gid ? A1 : A0) + (size_t)cur.pm * tstep + (cur.ks > 0 ? (size_t)cur.ks * ntq * kstep : 0); const char* cB = (const char*)(cur.gid ? B1 : B0) + (size_t)cur.pn * tstep + (cur.ks > 0 ? (size_t)cur.ks * ntq * kstep : 0);
    PG8_STAGE(PG8_SB(0, 0), cB, voffB); PG8_STAGE(PG8_SB(0, 1), cB + hstep, voffB); PG8_STAGE(PG8_SA(0, 0), cA, voffA); PG8_STAGE(PG8_SA(0, 1), cA + hstep, voffA);
    if (wr == 1) PG8_BAR;
    PG8_WAIT_V(2); PG8_BAR;
    PG8_STAGE(PG8_SB(1, 0), cB + kstep, voffB); PG8_STAGE(PG8_SA(1, 0), cA + kstep, voffA); PG8_STAGE(PG8_SB(1, 1), cB + hstep + kstep, voffB);
    PG8_WAIT_V(6); PG8_BAR;
    for (;;) {
        const bool has_next = S.next(ui + 1, nxt);
        const size_t nko = (has_next && nxt.ks > 0) ? (size_t)nxt.ks * ntq * kstep : 0;
        const char* nA = has_next ? (const char*)(nxt.gid ? A1 : A0) + (size_t)nxt.pm * tstep + nko : cA; const char* nB = has_next ? (const char*)(nxt.gid ? B1 : B0) + (size_t)nxt.pn * tstep + nko : cB;
        const int cnt = cur.ks < 0 ? nt : ntq;
        for (int t = 0; t < cnt; t += 2) {
            const bool last = (t == cnt - 2);
            const char* a1 = cA + (size_t)(t + 1) * kstep;
            const char* a2 = last ? nA : cA + (size_t)(t + 2) * kstep; const char* b2 = last ? nB : cB + (size_t)(t + 2) * kstep;
            const char* a3 = a2 + kstep; const char* b3 = b2 + kstep;
            PG8_LDB(Bf0, 0, 0); PG8_LDB(Bf1, 0, 1); PG8_SCHED; PG8_LDA(At, 0, 0); PG8_STAGE(PG8_SA(1, 1), a1 + hstep, voffA);
            PG8_WAIT_V(8); PG8_WAIT_L(0); PG8_BAR; PG8_MMA(0, 0, At, Bf0); PG8_MMA(0, 1, At, Bf1); PG8_BAR; PG8_SCHED;
            PG8_LDA(At, 0, 1); PG8_STAGE(PG8_SB(0, 0), b2, voffB); PG8_STAGE(PG8_SB(0, 1), b2 + hstep, voffB); PG8_STAGE(PG8_SA(0, 0), a2, voffA);
            PG8_WAIT_V(8); PG8_WAIT_L(0); PG8_BAR; PG8_MMA(1, 0, At, Bf0); PG8_MMA(1, 1, At, Bf1); PG8_BAR; PG8_SCHED;
            PG8_LDB(Bf0, 1, 0); PG8_LDB(Bf1, 1, 1); PG8_SCHED; PG8_LDA(At, 1, 0); PG8_STAGE(PG8_SA(0, 1), a2 + hstep, voffA);
            PG8_WAIT_V(8); PG8_WAIT_L(0); PG8_BAR; PG8_MMA(0, 0, At, Bf0); PG8_MMA(0, 1, At, Bf1); PG8_BAR; PG8_SCHED;
            PG8_LDA(At, 1, 1); PG8_STAGE(PG8_SB(1, 0), b3, voffB); PG8_STAGE(PG8_SB(1, 1), b3 + hstep, voffB); PG8_STAGE(PG8_SA(1, 0), a3, voffA);
            PG8_WAIT_V(8); PG8_WAIT_L(0); PG8_BAR; PG8_MMA(1, 0, At, Bf0); PG8_MMA(1, 1, At, Bf1); PG8_BAR; PG8_SCHED;
        }
        if (wr == 0) PG8_BAR;
        PG8_WAIT_V(0);
        E(acc, cur, wr, wc, fr, fq);
        if (!has_next) break;
#pragma unroll
        for (int a = 0; a < 2; ++a)
#pragma unroll
            for (int b = 0; b < 2; ++b)
#pragma unroll
                for (int m = 0; m < 4; ++m)
#pragma unroll
                    for (int n = 0; n < 2; ++n) acc[a][b][m][n] = (f32x4){0.f, 0.f, 0.f, 0.f};
        cur = nxt; cA = nA; cB = nB; ++ui;
        if (wr == 1) PG8_BAR;
    }
    PG8_WAIT_V(0);
    PG8_BAR;
#undef PG8_SA
#undef PG8_SB
#undef PG8_STAGE
#undef PG8_LDA
#undef PG8_LDB
#undef PG8_MMA
#undef PG8_WAIT_V
#undef PG8_WAIT_L
#undef PG8_BAR
#undef PG8_SCHED
}

#define FOR_AI_M _Pragma("unroll") for (int ai = 0; ai < 2; ++ai) _Pragma("unroll") for (int m = 0; m < 4; ++m)
#define FOR_BJ _Pragma("unroll") for (int bj = 0; bj < 2; ++bj)

struct EpiP1 {
    static constexpr bool MIDK = false;
    LAS float* X;
    bf16_t *QB, *KA, *VA, *BB, *CB, *UB, *MK, *MV;
    float *pk, *pv, *sk, *sv, *pmk, *pmv;
    const float *gq, *gk, *gxk; float c2;
    __device__ __forceinline__ void operator()(f32x4 (&acc)[2][2][4][2], const Unit& u, int wr, int wc, int fr, int fq) const {
        int hw = 0, kind = 0; const float* gain = nullptr; float sc = 1.f; bf16_t* ob; float* fp = nullptr; float* fs = nullptr;
        const int cb = (u.pn & 3) * 256;
        if (u.gid == 0) { const int seg = u.pn >> 2;
            if (seg == 0) { hw = 128; gain = gq; sc = c2; ob = QB; }
            else if (seg == 1) { hw = 128; gain = gk; ob = KA; fp = pk; fs = sk; kind = 1; }
            else if (seg == 2) { ob = VA; fp = pv; fs = sv; kind = 1; }
            else if (seg == 3) ob = BB; else { ob = CB; kind = 3; }
        } else { kind = 2; if (u.pn < 4) { hw = 256; gain = gxk; ob = MK; fp = pmk; } else { ob = MV; fp = pmv; } }
        float tot[2][4][2];
        if (hw) head_ss(acc, tot, X, wr, wc, fr, fq);
        f32x4 gv[2][2];
        FOR_BJ
#pragma unroll
            for (int n = 0; n < 2; ++n) gv[bj][n] = gain ? *(const f32x4*)(gain + (hw == 256 ? 128 * bj : 0) + 32 * wc + 8 * fq + 4 * n) : (f32x4){1.f, 1.f, 1.f, 1.f};
        FOR_AI_M {
            const int grow = u.pm * BM + ai * HALF + wr * 64 + m * 16 + fr;
            size_t brow = (size_t)grow; long frow = -1; float* fb = nullptr;
            if (kind == 2) { frow = grow; fb = fp; }
            else if (kind == 1) {
                if (grow < NPR) { const int t = grow & (SEQ - 1); if (t >= SEQ - 512) { frow = (long)(grow >> 13) * 512 + t - (SEQ - 512); fb = fp; } }
                else { const int s = grow - NPR, b = s >> 6, t = s & 63; brow = (size_t)NPR + (size_t)b * 576 + 512 + t; frow = (long)b * 512 + 448 + t; fb = fs; }
            }
            FOR_BJ {
                float sl = 1.f;
                if (hw) { const float t = (hw == 128) ? tot[ai][m][bj] : tot[ai][m][0] + tot[ai][m][1]; sl = rsqrtf(t / (float)hw + EPS) * sc; }
                const f32x4 v0 = acc[ai][bj][m][0] * sl * gv[bj][0], v1 = acc[ai][bj][m][1] * sl * gv[bj][1];
                const int col = cb + 128 * bj + 32 * wc + 8 * fq;
                if (kind == 3) {
                    if (bj == 0) *(u32x4*)(CB + brow * 1024 + (u.pn - 16) * 128 + 32 * wc + 8 * fq) = pack8(acc[ai][0][m][0] * acc[ai][1][m][0], acc[ai][0][m][1] * acc[ai][1][m][1]);
                    continue; }
                *(u32x4*)(ob + brow * 1024 + col) = pack8(v0, v1);
                if (fb) { *(f32x4*)(fb + (size_t)frow * 1024 + col) = v0; *(f32x4*)(fb + (size_t)frow * 1024 + col + 4) = v1; }
            }
            asm volatile("" ::: "memory");
        }
    }
};

struct EpiP3 {
    static constexpr bool MIDK = false;
    LAS float* X; const float *xp, *xs; bf16_t* HB; float* SS2;
    __device__ __forceinline__ void operator()(f32x4 (&acc)[2][2][4][2], const Unit& u, int wr, int wc, int fr, int fq) const {
        const float* xb = u.pm < NPR / BM ? xp : xs - (size_t)NPR * DM;
#pragma unroll
        for (int ai = 0; ai < 2; ++ai) {
            f32x4 xr[4][2][2];
#pragma unroll
            for (int m = 0; m < 4; ++m) FOR_BJ { const unsigned off = (unsigned)(u.pm * BM + ai * HALF + wr * 64 + m * 16 + fr) * DM + u.pn * BM + 128 * bj + 32 * wc + 8 * fq;
                xr[m][bj][0] = *(const f32x4*)(xb + off); xr[m][bj][1] = *(const f32x4*)(xb + off + 4); }
#pragma unroll
            for (int m = 0; m < 4; ++m) FOR_BJ { const unsigned off = (unsigned)(u.pm * BM + ai * HALF + wr * 64 + m * 16 + fr) * DM + u.pn * BM + 128 * bj + 32 * wc + 8 * fq;
                const f32x4 v0 = acc[ai][bj][m][0] + xr[m][bj][0], v1 = acc[ai][bj][m][1] + xr[m][bj][1];
                acc[ai][bj][m][0] = v0; acc[ai][bj][m][1] = v1;
                *(u32x4*)(HB + off) = pack8(v0, v1); }
            asm volatile("" ::: "memory");
        }
        float tot[2][4][2]; head_ss(acc, tot, X, wr, wc, fr, fq);
        if (wc == 0 && fq == 0) { FOR_AI_M { const int grow = u.pm * BM + ai * HALF + wr * 64 + m * 16 + fr; SS2[(size_t)grow * 8 + u.pn] = tot[ai][m][0] + tot[ai][m][1]; } }
    }
};

struct EpiP4 {
    static constexpr bool MIDK = false;
    LAS float* X; const float* SS2; const float* gxq; bf16_t* QX; float c2x;
    __device__ __forceinline__ void operator()(f32x4 (&acc)[2][2][4][2], const Unit& u, int wr, int wc, int fr, int fq) const {
        FOR_AI_M { const int grow = u.pm * BM + ai * HALF + wr * 64 + m * 16 + fr;
            const f32x4 a0 = *(const f32x4*)(SS2 + (size_t)grow * 8), a1 = *(const f32x4*)(SS2 + (size_t)grow * 8 + 4);
            const float r2 = rsqrtf(((a0[0] + a0[1]) + (a0[2] + a0[3]) + (a1[0] + a1[1]) + (a1[2] + a1[3])) * (1.f / 2048.f) + EPS);
            FOR_BJ { acc[ai][bj][m][0] *= r2; acc[ai][bj][m][1] *= r2; } }
        float tot[2][4][2]; head_ss(acc, tot, X, wr, wc, fr, fq);
        f32x4 gv[2][2];
        FOR_BJ
#pragma unroll
            for (int n = 0; n < 2; ++n) gv[bj][n] = *(const f32x4*)(gxq + 128 * bj + 32 * wc + 8 * fq + 4 * n);
        FOR_AI_M { const int grow = u.pm * BM + ai * HALF + wr * 64 + m * 16 + fr;
            const float s = rsqrtf((tot[ai][m][0] + tot[ai][m][1]) * (1.f / 256.f) + EPS) * c2x;
            FOR_BJ { const int col = u.pn * BM + 128 * bj + 32 * wc + 8 * fq;
                *(u32x4*)(QX + (size_t)grow * 1024 + col) = pack8(acc[ai][bj][m][0] * s * gv[bj][0], acc[ai][bj][m][1] * s * gv[bj][1]); } }
    }
};

struct EpiP6 {
    static constexpr bool MIDK = false;
    LAS float* X; bf16_t* H2B; float* SS3;
    __device__ __forceinline__ void operator()(f32x4 (&acc)[2][2][4][2], const Unit& u, int wr, int wc, int fr, int fq) const {
#pragma unroll
        for (int ai = 0; ai < 2; ++ai) {
            u32x4 hr[4][2];
#pragma unroll
            for (int m = 0; m < 4; ++m) FOR_BJ { const unsigned off = (unsigned)(u.pm * BM + ai * HALF + wr * 64 + m * 16 + fr) * DM + u.pn * BM + 128 * bj + 32 * wc + 8 * fq; hr[m][bj] = *(const u32x4*)(H2B + off); }
#pragma unroll
            for (int m = 0; m < 4; ++m) FOR_BJ { const unsigned off = (unsigned)(u.pm * BM + ai * HALF + wr * 64 + m * 16 + fr) * DM + u.pn * BM + 128 * bj + 32 * wc + 8 * fq;
                const u32x4 h = hr[m][bj];
                const f32x4 v0 = acc[ai][bj][m][0] + (f32x4){bflo(h.x), bfhi(h.x), bflo(h.y), bfhi(h.y)}, v1 = acc[ai][bj][m][1] + (f32x4){bflo(h.z), bfhi(h.z), bflo(h.w), bfhi(h.w)};
                acc[ai][bj][m][0] = v0; acc[ai][bj][m][1] = v1;
                *(u32x4*)(H2B + off) = pack8(v0, v1); }
            asm volatile("" ::: "memory");
        }
        float tot[2][4][2]; head_ss(acc, tot, X, wr, wc, fr, fq);
        if (wc == 0 && fq == 0) { FOR_AI_M { const int grow = u.pm * BM + ai * HALF + wr * 64 + m * 16 + fr; SS3[(size_t)grow * 8 + u.pn] = tot[ai][m][0] + tot[ai][m][1]; } }
    }
};

__device__ __forceinline__ float dpp_ror1(float v) { return __builtin_bit_cast(float, __builtin_amdgcn_update_dpp(0, __builtin_bit_cast(int, v), 0x121, 0xf, 0xf, false)); }
__device__ __forceinline__ float dpp_ror2(float v) { return __builtin_bit_cast(float, __builtin_amdgcn_update_dpp(0, __builtin_bit_cast(int, v), 0x122, 0xf, 0xf, false)); }
__device__ __forceinline__ float silu_mul(float cv, float g) { return cv * __builtin_amdgcn_rcpf(1.f + __builtin_amdgcn_exp2f(-cv * LOG2E)) * g; }
struct EpiP7 {
    static constexpr bool MIDK = false;
    LAS float* XH; const float* SS3; bf16_t* ACT; float *pf, *sf; const float* cffn; const float* wf; float *TAIL, *HEADU, *HEADG;
    __device__ __forceinline__ void operator()(f32x4 (&acc)[2][2][4][2], const Unit& u, int wr, int wc, int fr, int fq) const {
        const int f0 = u.pn * 128 + 32 * wc + 8 * fq;
        const bool smp = u.pm >= NPR / BM;
        FOR_AI_M { const int grow = u.pm * BM + ai * HALF + wr * 64 + m * 16 + fr;
            const f32x4 a0 = *(const f32x4*)(SS3 + (size_t)grow * 8), a1 = *(const f32x4*)(SS3 + (size_t)grow * 8 + 4);
            const float r3 = rsqrtf(((a0[0] + a0[1]) + (a0[2] + a0[3]) + (a1[0] + a1[1]) + (a1[2] + a1[3])) * (1.f / 2048.f) + EPS);
            FOR_BJ { acc[ai][bj][m][0] *= r3; acc[ai][bj][m][1] *= r3; } }
        if (fr >= 14) {
#pragma unroll
            for (int ai = 0; ai < 2; ++ai) { LAS float* xp = XH + ((2 * ai + wr) * 2 + (fr - 14)) * 128 + 32 * wc + 8 * fq; *(LAS f32x4*)xp = acc[ai][0][3][0]; *(LAS f32x4*)(xp + 4) = acc[ai][0][3][1]; } }
        EPI_BAR();
        FOR_AI_M { const int grow = u.pm * BM + ai * HALF + wr * 64 + m * 16 + fr;
            float* fo = nullptr;
            if (!smp) { const int t = grow & (SEQ - 1); if (t >= SEQ - 2) fo = pf + ((size_t)(grow >> 13) * 2 + (t - (SEQ - 2))) * DFF; }
            else { const int s = grow - NPR, t = s & 63; if (t >= 62) fo = sf + ((size_t)(s >> 6) * 2 + (t - 62)) * DFF; }
            if (fo) { *(f32x4*)(fo + f0) = acc[ai][0][m][0]; *(f32x4*)(fo + f0 + 4) = acc[ai][0][m][1]; } }
        if (!smp) {
            if (wr == 1 && fr >= 14) { float* tp = TAIL + ((size_t)u.pm * 2 + (fr - 14)) * DFF + f0; *(f32x4*)tp = acc[1][0][3][0]; *(f32x4*)(tp + 4) = acc[1][0][3][1]; }
            if (wr == 0 && fr < 2) { float* hp = HEADU + ((size_t)u.pm * 2 + fr) * DFF + f0; *(f32x4*)hp = acc[0][0][0][0]; *(f32x4*)(hp + 4) = acc[0][0][0][1];
                                     float* gp = HEADG + ((size_t)u.pm * 2 + fr) * DFF + f0; *(f32x4*)gp = acc[0][1][0][0]; *(f32x4*)(gp + 4) = acc[0][1][0][1]; }
        }
        f32x4 w0[2], w1[2], w2[2];
#pragma unroll
        for (int n = 0; n < 2; ++n) { w0[n] = *(const f32x4*)(wf + f0 + 4 * n); w1[n] = *(const f32x4*)(wf + DFF + f0 + 4 * n); w2[n] = *(const f32x4*)(wf + 2 * DFF + f0 + 4 * n); }
#pragma unroll
        for (int ai = 0; ai < 2; ++ai) {
            const int blk = 2 * ai + wr;
            f32x4 pv[2];
            if (smp) { const int b = (u.pm * BM - NPR) / 64 + blk; const float* cp = cffn + ((size_t)b * 2 + (fr == 15 ? 1 : 0)) * DFF + f0; pv[0] = *(const f32x4*)cp; pv[1] = *(const f32x4*)(cp + 4); }
            else if (blk == 0) { pv[0] = (f32x4){0.f, 0.f, 0.f, 0.f}; pv[1] = pv[0]; }
            else { const LAS float* xp = XH + ((blk - 1) * 2 + (fr == 15 ? 1 : 0)) * 128 + 32 * wc + 8 * fq; pv[0] = *(const LAS f32x4*)xp; pv[1] = *(const LAS f32x4*)(xp + 4); }
#pragma unroll
            for (int m = 0; m < 4; ++m) {
                const int grow = u.pm * BM + ai * HALF + wr * 64 + m * 16 + fr;
                f32x4 av[2];
#pragma unroll
                for (int n = 0; n < 2; ++n)
#pragma unroll
                    for (int e = 0; e < 4; ++e) {
                        const float cur = acc[ai][0][m][n][e], prv = pv[n][e];
                        const float a1 = dpp_ror1(cur), b1 = dpp_ror1(prv), a2 = dpp_ror2(cur), b2 = dpp_ror2(prv);
                        const float p1 = fr >= 1 ? a1 : b1, p2 = fr >= 2 ? a2 : b2;
                        const float cv = w0[n][e] * p2 + w1[n][e] * p1 + w2[n][e] * cur;
                        av[n][e] = silu_mul(cv, acc[ai][1][m][n][e]);
                    }
                *(u32x4*)(ACT + (size_t)grow * DFF + f0) = pack8(av[0], av[1]);
                pv[0] = acc[ai][0][m][0]; pv[1] = acc[ai][0][m][1];
            }
        }
    }
};

struct EpiP9 {
    static constexpr bool MIDK = false;
    float* Y; const bf16_t* H2B; float* PART;
    __device__ __forceinline__ void operator()(f32x4 (&acc)[2][2][4][2], const Unit& u, int wr, int wc, int fr, int fq) const {
        if (u.ks >= 0) {
            float* pp = PART + (size_t)(u.tail * 4 + u.ks) * 65536;
            FOR_AI_M FOR_BJ { float* yp = pp + (ai * HALF + wr * 64 + m * 16 + fr) * 256 + 128 * bj + 32 * wc + 8 * fq; *(f32x4*)yp = acc[ai][bj][m][0]; *(f32x4*)(yp + 4) = acc[ai][bj][m][1]; }
            return;
        }
#pragma unroll
        for (int ai = 0; ai < 2; ++ai) {
            u32x4 hr[4][2];
#pragma unroll
            for (int m = 0; m < 4; ++m) FOR_BJ { const unsigned off = (unsigned)(u.pm * BM + ai * HALF + wr * 64 + m * 16 + fr) * DM + u.pn * BM + 128 * bj + 32 * wc + 8 * fq; hr[m][bj] = *(const u32x4*)(H2B + off); }
#pragma unroll
            for (int m = 0; m < 4; ++m) FOR_BJ { const unsigned off = (unsigned)(u.pm * BM + ai * HALF + wr * 64 + m * 16 + fr) * DM + u.pn * BM + 128 * bj + 32 * wc + 8 * fq;
                const u32x4 h = hr[m][bj];
                *(f32x4*)(Y + off) = acc[ai][bj][m][0] + (f32x4){bflo(h.x), bfhi(h.x), bflo(h.y), bfhi(h.y)};
                *(f32x4*)(Y + off + 4) = acc[ai][bj][m][1] + (f32x4){bflo(h.z), bfhi(h.z), bflo(h.w), bfhi(h.w)}; }
            asm volatile("" ::: "memory");
        }
    }
};

#define VTR8(r, A0, A1, A2, A3) asm volatile( \
    "ds_read_b64_tr_b16 %0, %8\n\tds_read_b64_tr_b16 %1, %9\n\tds_read_b64_tr_b16 %2, %8 offset:4096\n\tds_read_b64_tr_b16 %3, %9 offset:4096\n\t" \
    "ds_read_b64_tr_b16 %4, %10\n\tds_read_b64_tr_b16 %5, %11\n\tds_read_b64_tr_b16 %6, %10 offset:4096\n\tds_read_b64_tr_b16 %7, %11 offset:4096" \
    : "=&v"(r[0]), "=&v"(r[1]), "=&v"(r[2]), "=&v"(r[3]), "=&v"(r[4]), "=&v"(r[5]), "=&v"(r[6]), "=&v"(r[7]) : "v"(A0), "v"(A1), "v"(A2), "v"(A3) : "memory")
#define VTRW(n, r, x, y) asm volatile("s_waitcnt lgkmcnt(" #n ")" : "+v"(r[0]), "+v"(r[1]), "+v"(r[2]), "+v"(r[3]), "+v"(r[4]), "+v"(r[5]), "+v"(r[6]), "+v"(r[7]), "+v"(x), "+v"(y) :: "memory")
#define VFR2(lo, hi2) ((bf16x8){lo[0], lo[1], lo[2], lo[3], hi2[0], hi2[1], hi2[2], hi2[3]})
__device__ __forceinline__ s16x4 vtr(const LAS unsigned char* p) { typedef short v4i16 __attribute__((ext_vector_type(4))); return __builtin_bit_cast(s16x4, __builtin_amdgcn_ds_read_tr16_b64_v4i16((LAS v4i16*)p)); }

template <int NKI, int NS, bool BAND>
__device__ __forceinline__ void attn_unit(LAS unsigned char* lds, const bf16_t* Kg, const bf16_t* Vg, const int colbase, const int nsteps, const bf16_t* Qg, const int nq,
                                          bf16_t* Og, const int ldo, float* ssa, const int head0, const int crel0, const LAS float* btab, const float cinit) {
    const int tid = threadIdx.x, lane = tid & 63, w = __builtin_amdgcn_readfirstlane(tid >> 6), hi = lane >> 5, l31 = lane & 31;
    constexpr int TILE = 8192, NT = NS * 2 * NKI, STG = NT * TILE;
    const int s = BAND ? (w >> 1) : 0, qb = BAND ? (w & 1) : (w >> 1), dsel = BAND ? 0 : (w & 1);
    const int col0 = colbase + s * 128 * NKI;
    const bool active = qb * 32 < nq;
    const int drow = 4 * w + (lane >> 4), fdr = ((drow & 3) << 2) | ((drow >> 2) & 3);
    const size_t goff = (size_t)drow * 2048 + (size_t)(((lane & 15) ^ fdr) << 4);
#define ATT_ISSUE(j_, stg_) do { const char* kb_ = (const char*)Kg + (size_t)(j_) * 65536 + goff; const char* vb_ = (const char*)Vg + (size_t)(j_) * 65536 + goff; \
        LAS unsigned char* d_ = lds + (stg_) * STG + w * 1024; \
        _Pragma("unroll") for (int s_ = 0; s_ < NS; ++s_) _Pragma("unroll") for (int i_ = 0; i_ < NKI; ++i_) { \
            const int cc_ = (colbase + s_ * 128 * NKI + i_ * 128) * 2; \
            __builtin_amdgcn_global_load_lds((const unsigned*)(kb_ + cc_), (LAS unsigned*)(d_ + (s_ * 2 * NKI + i_) * TILE), 16, 0, 0); \
            __builtin_amdgcn_global_load_lds((const unsigned*)(vb_ + cc_), (LAS unsigned*)(d_ + (s_ * 2 * NKI + NKI + i_) * TILE), 16, 0, 0); } } while (0)
    ATT_ISSUE(0, 0);
    bf16x8 qf[8 * NKI];
    if (active) { const bf16_t* qp = Qg + (size_t)(qb * 32 + l31) * 1024 + col0 + 8 * hi;
#pragma unroll
        for (int i = 0; i < 8 * NKI; ++i) qf[i] = *(const bf16x8*)(qp + 16 * i); }
    else {
#pragma unroll
        for (int i = 0; i < 8 * NKI; ++i) qf[i] = (bf16x8){0, 0, 0, 0, 0, 0, 0, 0}; }
    const int fl = ((l31 & 3) << 2) | ((l31 >> 2) & 3);
    int koff[8];
#pragma unroll
    for (int s8 = 0; s8 < 8; ++s8) koff[s8] = 256 * l31 + (((2 * s8 + hi) ^ fl) << 4);
    const int q4 = (lane & 15) >> 2, blk = (lane >> 4) & 1, p4 = lane & 3;
    int voff[2][4];
#pragma unroll
    for (int t = 0; t < 2; ++t)
#pragma unroll
        for (int c = 0; c < 4; ++c) voff[t][c] = 256 * (4 * hi + 8 * t + q4) + ((((c ^ q4) << 2) | ((2 * blk + (p4 >> 1)) ^ ((hi + 2 * t) & 3))) << 4) + 8 * (p4 & 1);
    f32x16 o[4];
#pragma unroll
    for (int c = 0; c < 4; ++c)
#pragma unroll
        for (int r = 0; r < 16; ++r) o[c][r] = 0.f;
    float lsum = 0.f;
    const LAS float* tb = btab + (head0 + s) * 264;
    const float cfar = BAND ? tb[256] : cinit;
    asm volatile("s_waitcnt vmcnt(0) lgkmcnt(0)" ::: "memory"); __builtin_amdgcn_s_barrier(); asm volatile("" ::: "memory");
    for (int j = 0; j < nsteps; ++j) {
        if (j + 1 < nsteps) ATT_ISSUE(j + 1, (j + 1) & 1);
        if (active) {
            const LAS unsigned char* st = lds + (j & 1) * STG;
            const LAS unsigned char* Kt = st + (s * 2 * NKI) * TILE; const LAS unsigned char* Vt = st + (s * 2 * NKI + NKI + dsel) * TILE;
            f32x16 sc;
            bool nearb = false;
            if (BAND) { const int kcrel = crel0 - (j >> 1); nearb = kcrel < 3;
                if (nearb) { const int dbase = 64 * kcrel - 32 * (j & 1) + qb * 32 + l31 - 4 * hi;
#pragma unroll
                    for (int r = 0; r < 16; ++r) { int d = dbase - ((r & 3) + 8 * (r >> 2)); d = d > 128 ? 128 : d; sc[r] = tb[d + 128]; } } }
            if (!nearb) {
#pragma unroll
                for (int r = 0; r < 16; ++r) sc[r] = cfar; }
#pragma unroll
            for (int i = 0; i < NKI; ++i) {
                bf16x8 kf[8];
#pragma unroll
                for (int s8 = 0; s8 < 8; ++s8) kf[s8] = *(const LAS bf16x8*)(Kt + i * TILE + koff[s8]);
                asm volatile("s_waitcnt lgkmcnt(0)" : "+v"(kf[0]), "+v"(kf[1]), "+v"(kf[2]), "+v"(kf[3]), "+v"(kf[4]), "+v"(kf[5]), "+v"(kf[6]), "+v"(kf[7]) :: "memory");
#pragma unroll
                for (int s8 = 0; s8 < 8; ++s8) sc = __builtin_amdgcn_mfma_f32_32x32x16_bf16(kf[s8], qf[i * 8 + s8], sc, 0, 0, 0);
            }
            s16x4 va[8], vb[8];
            { const unsigned sb = (unsigned)(size_t)Vt; VTR8(va, sb + voff[0][0], sb + voff[1][0], sb + voff[0][1], sb + voff[1][1]); VTR8(vb, sb + voff[0][2], sb + voff[1][2], sb + voff[0][3], sb + voff[1][3]); }
            float pe[16];
#pragma unroll
            for (int r = 0; r < 16; ++r) { pe[r] = __builtin_amdgcn_exp2f(sc[r]); lsum += pe[r]; }
            u32x4 pw0, pw1;
            pw0.x = cvtpk(pe[0], pe[1]); pw0.y = cvtpk(pe[2], pe[3]); pw0.z = cvtpk(pe[4], pe[5]); pw0.w = cvtpk(pe[6], pe[7]);
            pw1.x = cvtpk(pe[8], pe[9]); pw1.y = cvtpk(pe[10], pe[11]); pw1.z = cvtpk(pe[12], pe[13]); pw1.w = cvtpk(pe[14], pe[15]);
            VTRW(8, va, pw0, pw1);
            const bf16x8 pa0 = __builtin_bit_cast(bf16x8, pw0), pa1 = __builtin_bit_cast(bf16x8, pw1);
            o[0] = __builtin_amdgcn_mfma_f32_32x32x16_bf16(pa0, VFR2(va[0], va[1]), o[0], 0, 0, 0); o[0] = __builtin_amdgcn_mfma_f32_32x32x16_bf16(pa1, VFR2(va[2], va[3]), o[0], 0, 0, 0);
            o[1] = __builtin_amdgcn_mfma_f32_32x32x16_bf16(pa0, VFR2(va[4], va[5]), o[1], 0, 0, 0); o[1] = __builtin_amdgcn_mfma_f32_32x32x16_bf16(pa1, VFR2(va[6], va[7]), o[1], 0, 0, 0);
            VTRW(0, vb, pw0, pw1);
            o[2] = __builtin_amdgcn_mfma_f32_32x32x16_bf16(pa0, VFR2(vb[0], vb[1]), o[2], 0, 0, 0); o[2] = __builtin_amdgcn_mfma_f32_32x32x16_bf16(pa1, VFR2(vb[2], vb[3]), o[2], 0, 0, 0);
            o[3] = __builtin_amdgcn_mfma_f32_32x32x16_bf16(pa0, VFR2(vb[4], vb[5]), o[3], 0, 0, 0); o[3] = __builtin_amdgcn_mfma_f32_32x32x16_bf16(pa1, VFR2(vb[6], vb[7]), o[3], 0, 0, 0);
        }
        asm volatile("s_waitcnt vmcnt(0) lgkmcnt(0)" ::: "memory"); __builtin_amdgcn_s_barrier(); asm volatile("" ::: "memory");
    }
#undef ATT_ISSUE
    LAS unsigned char* stg = lds + w * 8704;
    LAS float* lsc = (LAS float*)(lds + LSC_OFF) + w * 32;
    if (active) {
        const float l = lsum + __shfl_xor(lsum, 32);
        if (hi == 0) lsc[l31] = l;
        asm volatile("s_waitcnt lgkmcnt(0)" ::: "memory");
#pragma unroll
        for (int r = 0; r < 16; ++r) { const int q = (r & 3) + 8 * (r >> 2) + 4 * hi; const float rl = 1.f / lsc[q];
#pragma unroll
            for (int c = 0; c < 4; ++c) *(LAS bf16_t*)(stg + q * 272 + (32 * c + l31) * 2) = (bf16_t)f2bf(o[c][r] * rl); }
        asm volatile("s_waitcnt lgkmcnt(0)" ::: "memory");
        const int row = lane >> 1, half = lane & 1;
        bf16_t* op = Og + (size_t)(qb * 32 + row) * ldo + col0 + dsel * 128 + half * 64;
        float ss = 0.f;
#pragma unroll
        for (int i = 0; i < 8; ++i) { const u32x4 v = *(const LAS u32x4*)(stg + row * 272 + half * 128 + i * 16);
            ss += bflo(v.x) * bflo(v.x) + bfhi(v.x) * bfhi(v.x) + bflo(v.y) * bflo(v.y) + bfhi(v.y) * bfhi(v.y) + bflo(v.z) * bflo(v.z) + bfhi(v.z) * bfhi(v.z) + bflo(v.w) * bflo(v.w) + bfhi(v.w) * bfhi(v.w);
            *(u32x4*)(op + i * 8) = v; }
        if (BAND) { ss += __shfl_xor(ss, 1); if (half == 0) ssa[(size_t)(qb * 32 + row) * 8 + head0 + s] = ss; }
    }
    asm volatile("s_waitcnt lgkmcnt(0)" ::: "memory"); __builtin_amdgcn_s_barrier(); asm volatile("" ::: "memory");
}

template <int D>
__device__ __forceinline__ void band_unit(LAS unsigned char* lds, const bf16_t* Kg, const bf16_t* Vg, const int ntile, const bf16_t* Qg, bf16_t* Og, float* ssa, const int nci, const int crel0, const LAS float* tb) {
    const int tid = threadIdx.x, lane = tid & 63, w = __builtin_amdgcn_readfirstlane(tid >> 6), hi = lane >> 5, l31 = lane & 31;
    constexpr int STG = 16384;
    const int ci = w >> 1, qb = w & 1;
    const bool wact = ci < nci;
    const int drow = 4 * w + (lane >> 4), fdr = ((drow & 3) << 2) | ((drow >> 2) & 3);
    const size_t goff = (size_t)drow * 2048 + (size_t)(((lane & 15) ^ fdr) << 4);
#define BISSUE(j_) do { LAS unsigned char* d_ = lds + ((j_) & (D - 1)) * STG + w * 1024; \
        __builtin_amdgcn_global_load_lds((const unsigned*)((const char*)Kg + (size_t)(j_) * 65536 + goff), (LAS unsigned*)d_, 16, 0, 0); \
        __builtin_amdgcn_global_load_lds((const unsigned*)((const char*)Vg + (size_t)(j_) * 65536 + goff), (LAS unsigned*)(d_ + 8192), 16, 0, 0); } while (0)
    bf16x8 qf[8];
    if (wact) { const bf16_t* qp = Qg + (size_t)(64 * ci + 32 * qb + l31) * 1024 + 8 * hi;
#pragma unroll
        for (int i = 0; i < 8; ++i) qf[i] = *(const bf16x8*)(qp + 16 * i); }
    else {
#pragma unroll
        for (int i = 0; i < 8; ++i) qf[i] = (bf16x8){0, 0, 0, 0, 0, 0, 0, 0}; }
#pragma unroll
    for (int j = 0; j < 4; ++j) if (j < ntile) BISSUE(j);
    const int fl = ((l31 & 3) << 2) | ((l31 >> 2) & 3);
    int koff[8];
#pragma unroll
    for (int s8 = 0; s8 < 8; ++s8) koff[s8] = 256 * l31 + (((2 * s8 + hi) ^ fl) << 4);
    const int q4 = (lane & 15) >> 2, blk = (lane >> 4) & 1, p4 = lane & 3;
    int voff[2][4];
#pragma unroll
    for (int t = 0; t < 2; ++t)
#pragma unroll
        for (int c = 0; c < 4; ++c) voff[t][c] = 8192 + 256 * (4 * hi + 8 * t + q4) + ((((c ^ q4) << 2) | ((2 * blk + (p4 >> 1)) ^ ((hi + 2 * t) & 3))) << 4) + 8 * (p4 & 1);
    f32x16 o[4];
#pragma unroll
    for (int c = 0; c < 4; ++c)
#pragma unroll
        for (int r = 0; r < 16; ++r) o[c][r] = 0.f;
    float lsum = 0.f;
    const float cfar = tb[256];
    for (int j = 0; j < ntile; ++j) {
        if ((j & 3) == 0) {
            asm volatile("s_waitcnt vmcnt(0)" ::: "memory");
            __builtin_amdgcn_s_barrier(); asm volatile("" ::: "memory");
#pragma unroll
            for (int jj = 4; jj < 8; ++jj) if (j + jj < ntile) BISSUE(j + jj);
        }
        const int kcrel = crel0 + ci - (j >> 1);
        if (wact && kcrel >= 0 && kcrel <= 8) {
            const LAS unsigned char* st = lds + (j & (D - 1)) * STG;
            f32x16 sc;
            if (kcrel < 3) { const int dbase = 64 * kcrel - 32 * (j & 1) + qb * 32 + l31 - 4 * hi;
#pragma unroll
                for (int r = 0; r < 16; ++r) { int d = dbase - ((r & 3) + 8 * (r >> 2)); d = d > 128 ? 128 : d; sc[r] = tb[d + 128]; } }
            else {
#pragma unroll
                for (int r = 0; r < 16; ++r) sc[r] = cfar; }
            bf16x8 kf[8];
#pragma unroll
            for (int s8 = 0; s8 < 8; ++s8) kf[s8] = *(const LAS bf16x8*)(st + koff[s8]);
            asm volatile("s_waitcnt lgkmcnt(0)" : "+v"(kf[0]), "+v"(kf[1]), "+v"(kf[2]), "+v"(kf[3]), "+v"(kf[4]), "+v"(kf[5]), "+v"(kf[6]), "+v"(kf[7]) :: "memory");
#pragma unroll
            for (int s8 = 0; s8 < 8; ++s8) sc = __builtin_amdgcn_mfma_f32_32x32x16_bf16(kf[s8], qf[s8], sc, 0, 0, 0);
            s16x4 va[8], vb[8];
            { const unsigned sb = (unsigned)(size_t)st; VTR8(va, sb + voff[0][0], sb + voff[1][0], sb + voff[0][1], sb + voff[1][1]); VTR8(vb, sb + voff[0][2], sb + voff[1][2], sb + voff[0][3], sb + voff[1][3]); }
            float pe[16];
#pragma unroll
            for (int r = 0; r < 16; ++r) { pe[r] = __builtin_amdgcn_exp2f(sc[r]); lsum += pe[r]; }
            u32x4 pw0, pw1;
            pw0.x = cvtpk(pe[0], pe[1]); pw0.y = cvtpk(pe[2], pe[3]); pw0.z = cvtpk(pe[4], pe[5]); pw0.w = cvtpk(pe[6], pe[7]);
            pw1.x = cvtpk(pe[8], pe[9]); pw1.y = cvtpk(pe[10], pe[11]); pw1.z = cvtpk(pe[12], pe[13]); pw1.w = cvtpk(pe[14], pe[15]);
            VTRW(8, va, pw0, pw1);
            const bf16x8 pa0 = __builtin_bit_cast(bf16x8, pw0), pa1 = __builtin_bit_cast(bf16x8, pw1);
            o[0] = __builtin_amdgcn_mfma_f32_32x32x16_bf16(pa0, VFR2(va[0], va[1]), o[0], 0, 0, 0); o[0] = __builtin_amdgcn_mfma_f32_32x32x16_bf16(pa1, VFR2(va[2], va[3]), o[0], 0, 0, 0);
            o[1] = __builtin_amdgcn_mfma_f32_32x32x16_bf16(pa0, VFR2(va[4], va[5]), o[1], 0, 0, 0); o[1] = __builtin_amdgcn_mfma_f32_32x32x16_bf16(pa1, VFR2(va[6], va[7]), o[1], 0, 0, 0);
            VTRW(0, vb, pw0, pw1);
            o[2] = __builtin_amdgcn_mfma_f32_32x32x16_bf16(pa0, VFR2(vb[0], vb[1]), o[2], 0, 0, 0); o[2] = __builtin_amdgcn_mfma_f32_32x32x16_bf16(pa1, VFR2(vb[2], vb[3]), o[2], 0, 0, 0);
            o[3] = __builtin_amdgcn_mfma_f32_32x32x16_bf16(pa0, VFR2(vb[4], vb[5]), o[3], 0, 0, 0); o[3] = __builtin_amdgcn_mfma_f32_32x32x16_bf16(pa1, VFR2(vb[6], vb[7]), o[3], 0, 0, 0);
        }
    }
#undef BISSUE
    asm volatile("s_waitcnt vmcnt(0) lgkmcnt(0)" ::: "memory"); __builtin_amdgcn_s_barrier(); asm volatile("" ::: "memory");
    LAS unsigned char* stg = lds + w * 8704;
    LAS float* lsc = (LAS float*)(lds + LSC_OFF) + w * 32;
    if (wact) {
        const float l = lsum + __shfl_xor(lsum, 32);
        if (hi == 0) lsc[l31] = l;
        asm volatile("s_waitcnt lgkmcnt(0)" ::: "memory");
#pragma unroll
        for (int r = 0; r < 16; ++r) { const int q = (r & 3) + 8 * (r >> 2) + 4 * hi; const float rl = 1.f / lsc[q];
#pragma unroll
            for (int c = 0; c < 4; ++c) *(LAS bf16_t*)(stg + q * 272 + (32 * c + l31) * 2) = (bf16_t)f2bf(o[c][r] * rl); }
        asm volatile("s_waitcnt lgkmcnt(0)" ::: "memory");
        const int row = lane >> 1, half = lane & 1, orow = 64 * ci + 32 * qb + row;
        bf16_t* op = Og + (size_t)orow * DM + half * 64;
        float ss = 0.f;
#pragma unroll
        for (int i = 0; i < 8; ++i) { const u32x4 v = *(const LAS u32x4*)(stg + row * 272 + half * 128 + i * 16);
            ss += bflo(v.x) * bflo(v.x) + bfhi(v.x) * bfhi(v.x) + bflo(v.y) * bflo(v.y) + bfhi(v.y) * bfhi(v.y) + bflo(v.z) * bflo(v.z) + bfhi(v.z) * bfhi(v.z) + bflo(v.w) * bflo(v.w) + bfhi(v.w) * bfhi(v.w);
            *(u32x4*)(op + i * 8) = v; }
        ss += __shfl_xor(ss, 1); if (half == 0) ssa[(size_t)orow * 8] = ss;
    }
    asm volatile("s_waitcnt lgkmcnt(0)" ::: "memory"); __builtin_amdgcn_s_barrier(); asm volatile("" ::: "memory");
}

__device__ __forceinline__ void p0_transpose_item(const float* W, int K, int N, bf16_t* WT, int mode, const float* ga, const float* gb, int ksplit, LAS float* scr, int item, int lane) {
    const int nblk = N / 32, kb = item / nblk, nb = item % nblk, k0 = 64 * kb, n0 = 32 * nb;
    const float* g = ga ? (k0 < ksplit ? ga + k0 : gb + (k0 - ksplit)) : nullptr;
    f32x4 wv[8];
#pragma unroll
    for (int i = 0; i < 8; ++i) wv[i] = __builtin_nontemporal_load((const f32x4*)(W + (size_t)(k0 + 8 * i + (lane >> 3)) * N + n0 + 4 * (lane & 7)));
#pragma unroll
    for (int i = 0; i < 8; ++i) { const int kk = 8 * i + (lane >> 3); const float gg = g ? g[kk] : 1.f; LAS float* sp = scr + kk * 33 + 4 * (lane & 7);
        sp[0] = wv[i][0] * gg; sp[1] = wv[i][1] * gg; sp[2] = wv[i][2] * gg; sp[3] = wv[i][3] * gg; }
    asm volatile("s_waitcnt lgkmcnt(0)" ::: "memory");
    const int c = lane & 7;
#pragma unroll
    for (int j = 0; j < 4; ++j) { const int n = (lane >> 3) + 8 * j; const LAS float* sp = scr + (8 * c) * 33 + n;
        u32x4 o; o.x = cvtpk(sp[0 * 33], sp[1 * 33]); o.y = cvtpk(sp[2 * 33], sp[3 * 33]); o.z = cvtpk(sp[4 * 33], sp[5 * 33]); o.w = cvtpk(sp[6 * 33], sp[7 * 33]);
        const int nn = n0 + n; const int orow = mode == 0 ? nn : (mode == 3 ? (nn < 4096 ? nn : 4096 + (((nn - 4096) & 1023) >> 7) * 256 + (nn >= 5120 ? 128 : 0) + (nn & 127)) : ((nn >> 7) * 256 + (nn & 127) + (mode == 2 ? 128 : 0)));
        *(u32x4*)(WT + (size_t)orow * K + k0 + 8 * c) = o; }
    asm volatile("s_waitcnt lgkmcnt(0)" ::: "memory");
}
__device__ __forceinline__ void rms_row_to_bf16(const float* xrow, const float* g, bf16_t* orow, int lane) {
    const f32x4* xr = (const f32x4*)xrow + lane; const f32x4* gr = (const f32x4*)g + lane;
    f32x4 v[8]; float s = 0.f;
#pragma unroll
    for (int j = 0; j < 8; ++j) { v[j] = __builtin_nontemporal_load(xr + 64 * j); s += (v[j][0] * v[j][0] + v[j][1] * v[j][1]) + (v[j][2] * v[j][2] + v[j][3] * v[j][3]); }
    const float r = rsqrtf(wave_sum(s) * (1.f / 2048.f) + EPS);
    u32x2* o8 = (u32x2*)orow + lane;
#pragma unroll
    for (int j = 0; j < 8; ++j) { const f32x4 gg = gr[64 * j]; u32x2 o; o.x = cvtpk(v[j][0] * r * gg[0], v[j][1] * r * gg[1]); o.y = cvtpk(v[j][2] * r * gg[2], v[j][3] * r * gg[3]); o8[64 * j] = o; }
}
__device__ __forceinline__ void cvt_row_1024(const float* src, bf16_t* dst, float* fcopy, int lane) {
    const f32x4* xr = (const f32x4*)src + lane; u32x2* o8 = (u32x2*)dst + lane;
#pragma unroll
    for (int j = 0; j < 4; ++j) { const f32x4 v = xr[64 * j]; u32x2 o; o.x = cvtpk(v[0], v[1]); o.y = cvtpk(v[2], v[3]); o8[64 * j] = o; if (fcopy) ((f32x4*)fcopy + lane)[64 * j] = v; }
}

#define XB_TMO      128
#define XB_XCNT(j)  (256  + 64 * (j))
#define XB_XSUB(j)  (1280 + 64 * (j))
#define XB_XGEN(j)  (2304 + 64 * (j))
#define XB_TOP      3328
#define XB_TOPGEN   3392
#define XCD_BAR_WORDS 3456
#define XB_SPIN_CAP (1u << 20)
__device__ __forceinline__ unsigned xb_ld(unsigned* p)              { return __hip_atomic_load(p, __ATOMIC_RELAXED, __HIP_MEMORY_SCOPE_AGENT); }
__device__ __forceinline__ unsigned xb_add(unsigned* p, unsigned v) { return __hip_atomic_fetch_add(p, v, __ATOMIC_RELAXED, __HIP_MEMORY_SCOPE_AGENT); }
__device__ __forceinline__ unsigned xb_xcc_id() { return (unsigned)__builtin_amdgcn_s_getreg((3 << 11) | 20) & 0xFu; }
#define XB_SPIN(cond, bar) do { unsigned _sp = 0; while (cond) { __builtin_amdgcn_s_sleep(1); \
    if ((++_sp & 255u) == 0u) { if (xb_ld(&(bar)[XB_TMO])) break; if (_sp > XB_SPIN_CAP) { atomicAdd(&(bar)[XB_TMO], 1u); break; } } } } while (0)
struct XcdBarrier { unsigned* bar; unsigned x; volatile LAS unsigned* st; };
__device__ __forceinline__ XcdBarrier xcd_barrier_post(unsigned* bar, volatile LAS unsigned* st) {
    XcdBarrier b; b.bar = bar; b.x = xb_xcc_id(); b.st = st;
    if (threadIdx.x == 0) (void)xb_add(&bar[XB_XCNT(b.x)], 1u);
    return b;
}
__device__ __forceinline__ void xcd_barrier_complete(unsigned* bar, unsigned x, unsigned& nloc, unsigned& nx) {
    const unsigned G = gridDim.x * gridDim.y * gridDim.z;
    unsigned sum, cnt, mine, sp = 0u;
    for (;;) {
        sum = 0u; cnt = 0u; mine = 0u;
#pragma unroll
        for (unsigned j = 0; j < 16; ++j) { const unsigned c = xb_ld(&bar[XB_XCNT(j)]); sum += c; cnt += (c > 0u) ? 1u : 0u; mine = (j == x) ? c : mine; }
        if (sum == G) break;
        __builtin_amdgcn_s_sleep(1);
        if ((++sp & 255u) == 0u) { if (xb_ld(&bar[XB_TMO])) break; if (sp > XB_SPIN_CAP) { atomicAdd(&bar[XB_TMO], 1u); break; } }
    }
    nloc = mine > 0u ? mine : 1u; nx = cnt > 0u ? cnt : 1u;
}
__device__ __forceinline__ void xcd_barrier(const XcdBarrier& b) {
    asm volatile("s_waitcnt vmcnt(0)" ::: "memory");
    __syncthreads();
    if (threadIdx.x == 0) {
        unsigned* bar = b.bar;
        __builtin_amdgcn_s_waitcnt(0);
        unsigned nloc = b.st[0], nx = b.st[1];
        if (nloc == 0u) { xcd_barrier_complete(bar, b.x, nloc, nx); b.st[0] = nloc; b.st[1] = nx; }
        const unsigned old = xb_add(&bar[XB_XSUB(b.x)], 1u);
        const unsigned gen = old / nloc;
        if (old + 1u == (gen + 1u) * nloc) {
            __builtin_amdgcn_fence(__ATOMIC_RELEASE, "agent");
            asm volatile("s_waitcnt vmcnt(0)" ::: "memory");
            const unsigned og = xb_add(&bar[XB_TOP], 1u);
            const unsigned tg = og / nx;
            if (og + 1u == (tg + 1u) * nx) xb_add(&bar[XB_TOPGEN], 1u);
            else XB_SPIN(xb_ld(&bar[XB_TOPGEN]) == tg, bar);
            __builtin_amdgcn_fence(__ATOMIC_ACQUIRE, "agent");
            xb_add(&bar[XB_XGEN(b.x)], 1u);
            asm volatile("s_waitcnt vmcnt(0)" ::: "memory");
        } else {
            XB_SPIN(xb_ld(&bar[XB_XGEN(b.x)]) == gen, bar);
            __builtin_amdgcn_fence(__ATOMIC_ACQUIRE, "agent");
            asm volatile("s_waitcnt vmcnt(0)" ::: "memory");
        }
    }
    __syncthreads();
}

struct Args { const float* in[30]; float* out; unsigned char* ws; int ph_lo, ph_hi, li, pad; };

__global__ void __launch_bounds__(512, 2) fwd_kernel(Args a) {
    extern __shared__ __attribute__((aligned(16))) unsigned char lds_raw[];
    LAS unsigned char* lds = (LAS unsigned char*)lds_raw;
    cg::grid_group grid = cg::this_grid();
    const int tid = threadIdx.x, lane = tid & 63, wave = __builtin_amdgcn_readfirstlane(tid >> 6);
    const int G = gridDim.x, bid = blockIdx.x;
    const int gw = bid * 8 + wave, NGW = G * 8;
    unsigned char* ws = a.ws;
    const float *x_p = a.in[0], *x_s = a.in[1], *mem_p = a.in[2], *c_k = a.in[3], *c_v = a.in[4], *c_conv = a.in[5], *c_ffn = a.in[6], *c_mk = a.in[7], *c_mv = a.in[8];
    const float *g_norm1 = a.in[9], *w_in = a.in[10], *g_q = a.in[11], *g_k = a.in[12], *rel_bias = a.in[13], *w_cmix = a.in[14], *g_oa = a.in[15], *g_oc = a.in[16], *w_out = a.in[17];
    const float *g_norm2 = a.in[18], *g_memn = a.in[19], *w_xq = a.in[20], *w_xkv = a.in[21], *g_xq = a.in[22], *g_xk = a.in[23], *w_xo = a.in[24], *g_norm3 = a.in[25];
    const float *w_up = a.in[26], *w_gate = a.in[27], *w_fconv = a.in[28], *w_down = a.in[29];
    float* out = a.out;
    float* Y = out;
    float* o_pk = out + (size_t)MT * DM; float* o_pv = o_pk + 2097152; float* o_pc = o_pv + 2097152; float* o_pf = o_pc + 8192; float* o_pmk = o_pf + 45056; float* o_pmv = o_pmk + 1048576;
    float* o_sk = o_pmv + 1048576; float* o_sv = o_sk + 16777216; float* o_sc = o_sv + 16777216; float* o_sf = o_sc + 65536;
    float* SSA = (float*)(ws + WS_SSA); float* SSB = (float*)(ws + WS_SSB); float* SS2 = (float*)(ws + WS_SS2); float* SS3 = (float*)(ws + WS_SS3);
    bf16_t* WUG = (bf16_t*)(ws + WS_WUG); bf16_t* WDN = (bf16_t*)(ws + WS_WDN); bf16_t* WIN = (bf16_t*)(ws + WS_WIN); bf16_t* WOUT = (bf16_t*)(ws + WS_WOUT);
    bf16_t* WXQ = (bf16_t*)(ws + WS_WXQ); bf16_t* WXKV = (bf16_t*)(ws + WS_WXKV); bf16_t* WXO = (bf16_t*)(ws + WS_WXO);
    bf16_t* XN = (bf16_t*)(ws + WS_XN); bf16_t* HB = (bf16_t*)(ws + WS_HB); bf16_t* H2B = (bf16_t*)(ws + WS_H2B);
    bf16_t* QB = (bf16_t*)(ws + WS_QB); bf16_t* KA = (bf16_t*)(ws + WS_KA); bf16_t* VA = (bf16_t*)(ws + WS_VA); bf16_t* BBf = (bf16_t*)(ws + WS_BB); bf16_t* CBf = (bf16_t*)(ws + WS_CB); bf16_t* UBf = (bf16_t*)(ws + WS_UB);
    bf16_t* MIX = (bf16_t*)(ws + WS_MIX); bf16_t* QX = (bf16_t*)(ws + WS_QX); bf16_t* XO = (bf16_t*)(ws + WS_XO); bf16_t* UP = (bf16_t*)(ws + WS_UP); bf16_t* GATE = (bf16_t*)(ws + WS_GATE);
    float* TAILB = (float*)(ws + WS_TAIL); float* HEADU = (float*)(ws + WS_HEADU); float* HEADG = (float*)(ws + WS_HEADG);
    bf16_t* MEMN = (bf16_t*)(ws + WS_MEMN); bf16_t* MKA = (bf16_t*)(ws + WS_MKA); bf16_t* MVA = (bf16_t*)(ws + WS_MVA);
    LAS float* XCH = (LAS float*)(lds + XCH_OFF);
    const int lo = a.ph_lo, hi_ph = a.ph_hi;
#ifdef ONLY_PHASE
#define IN(k) ((k) == ONLY_PHASE && lo <= (k) && (k) < hi_ph)
#else
#define IN(k) (lo <= (k) && (k) < hi_ph)
#endif
#define SEAM(k) do { if (IN(k) && IN((k) + 1)) xcd_barrier(xbar); } while (0)
    if (a.ph_hi < 0) grid.sync();
    volatile LAS unsigned* MISC = (volatile LAS unsigned*)(lds + MISC_OFF);
    if (tid < 2) MISC[tid] = 0u;
    __syncthreads();
    XcdBarrier xbar = xcd_barrier_post((unsigned*)ws + a.li * XCD_BAR_WORDS, MISC);

    if (IN(0)) {
        LAS float* scr = (LAS float*)(lds + wave * 16384);
        constexpr int I_UP = 32 * 176, I_DN = 88 * 64, I_IN = 32 * 192, I_OUT = 32 * 64, I_XQ = 32 * 32, I_XKV = 32 * 64, I_XO = 16 * 64;
        constexpr int T0 = I_UP, T1 = T0 + I_UP, T2 = T1 + I_DN, T3 = T2 + I_IN, T4 = T3 + I_OUT, T5 = T4 + I_XQ, T6 = T5 + I_XKV, T7 = T6 + I_XO;
        for (int it = gw; it < T7; it += NGW) {
            if (it < T0) p0_transpose_item(w_up, DM, DFF, WUG, 1, g_norm3, g_norm3, 1 << 30, scr, it, lane);
            else if (it < T1) p0_transpose_item(w_gate, DM, DFF, WUG, 2, g_norm3, g_norm3, 1 << 30, scr, it - T0, lane);
            else if (it < T2) p0_transpose_item(w_down, DFF, DM, WDN, 0, nullptr, nullptr, 0, scr, it - T1, lane);
            else if (it < T3) p0_transpose_item(w_in, DM, 6144, WIN, 3, nullptr, nullptr, 0, scr, it - T2, lane);
            else if (it < T4) p0_transpose_item(w_out, DM, DM, WOUT, 0, g_oa, g_oc, 1024, scr, it - T3, lane);
            else if (it < T5) p0_transpose_item(w_xq, DM, 1024, WXQ, 0, g_norm2, g_norm2, 1 << 30, scr, it - T4, lane);
            else if (it < T6) p0_transpose_item(w_xkv, DM, DM, WXKV, 0, nullptr, nullptr, 0, scr, it - T5, lane);
            else p0_transpose_item(w_xo, 1024, DM, WXO, 0, nullptr, nullptr, 0, scr, it - T6, lane);
        }
        for (int r = gw; r < MT + 1024; r += NGW) {
            const float* src = r < NPR ? x_p + (size_t)r * DM : (r < MT ? x_s + (size_t)(r - NPR) * DM : mem_p + (size_t)(r - MT) * DM);
            rms_row_to_bf16(src, r < MT ? g_norm1 : g_memn, (r < MT ? XN : MEMN - (size_t)MT * DM) + (size_t)r * DM, lane);
        }
        for (int r4 = gw; r4 < (2 * 16384 + 2 * 8192) / 4; r4 += NGW) {
            f32x4 v[4][4]; bf16_t* dst[4]; float* fc[4];
#pragma unroll
            for (int q = 0; q < 4; ++q) { const int r = r4 * 4 + q; const float* src;
                if (r < 32768) { const int kv = r >> 14, rr = r & 16383, b = rr >> 9, j = rr & 511;
                    src = (kv ? c_v : c_k) + (size_t)rr * 1024; dst[q] = (kv ? VA : KA) + ((size_t)NPR + (size_t)b * 576 + j) * 1024;
                    fc[q] = j >= 64 ? (kv ? o_sv : o_sk) + ((size_t)b * 512 + j - 64) * 1024 : nullptr; }
                else { const int r2 = r - 32768, kv = r2 >> 13, rr = r2 & 8191; src = (kv ? c_mv : c_mk) + (size_t)rr * 1024; dst[q] = (kv ? MVA : MKA) + ((size_t)1024 + rr) * 1024; fc[q] = nullptr; }
#pragma unroll
                for (int j = 0; j < 4; ++j) v[q][j] = __builtin_nontemporal_load((const f32x4*)src + lane + 64 * j); }
#pragma unroll
            for (int q = 0; q < 4; ++q)
#pragma unroll
                for (int j = 0; j < 4; ++j) { u32x2 o; o.x = cvtpk(v[q][j][0], v[q][j][1]); o.y = cvtpk(v[q][j][2], v[q][j][3]); ((u32x2*)dst[q] + lane)[64 * j] = o; if (fc[q]) __builtin_nontemporal_store(v[q][j], (f32x4*)fc[q] + lane + 64 * j); }
        }
    }
    SEAM(0);

    if (IN(1)) {
        Order S; S.init(MT, 6144, G, bid, 1024, 8);
        EpiP1 E{XCH, QB, KA, VA, BBf, CBf, UBf, MKA, MVA, o_pk, o_pv, o_sk, o_sv, o_pmk, o_pmv, g_q, g_k, g_xk, 0.08838834764831845f * LOG2E};
        gemm_phase<EpiP1>(lds, XN, WIN, MEMN, WXKV, DM, S, E);
    }
    SEAM(1);

    if (IN(2)) {
        LAS float* btab = (LAS float*)(lds + BT_OFF);
        {
            const float gqm = wave_max(fmaxf(fabsf(g_q[lane]), fabsf(g_q[lane + 64]))), gkm = wave_max(fmaxf(fabsf(g_k[lane]), fabsf(g_k[lane + 64])));
            float tm = -1e30f; for (int j = lane; j < 257; j += 64) tm = fmaxf(tm, rel_bias[wave * 257 + j]);
            tm = wave_max(tm);
            const float Mh = 11.313708498984761f * gqm * gkm * 1.01f + tm;
            for (int j = lane; j < 257; j += 64) btab[wave * 264 + j] = (rel_bias[wave * 257 + j] - Mh) * LOG2E;
        }
        asm volatile("s_waitcnt lgkmcnt(0)" ::: "memory"); __builtin_amdgcn_s_barrier(); asm volatile("" ::: "memory");
        for (int un = bid; un < 1024 + 256; un += G) {
            if (un < 1024) { const int h = un & 7, bg = un >> 3, b = bg >> 5, c0 = (bg & 31) * 4, klo = c0 > 8 ? c0 - 8 : 0;
                const size_t krow0 = (size_t)b * SEQ + 64 * klo, qrow0 = (size_t)b * SEQ + 64 * c0;
                band_unit<8>(lds, KA + krow0 * 1024 + h * 128, VA + krow0 * 1024 + h * 128, 2 * (c0 + 4 - klo), QB + qrow0 * 1024 + h * 128, MIX + qrow0 * DM + h * 128, SSA + qrow0 * 8 + h, 4, c0 - klo, btab + h * 264); }
            else { const int su = un - 1024, h = su & 7, b = su >> 3;
                const size_t krow0 = (size_t)NPR + (size_t)b * 576, qrow0 = (size_t)NPR + 64 * b;
                band_unit<8>(lds, KA + krow0 * 1024 + h * 128, VA + krow0 * 1024 + h * 128, 18, QB + qrow0 * 1024 + h * 128, MIX + qrow0 * DM + h * 128, SSA + qrow0 * 8 + h, 1, 8, btab + h * 264); }
        }
    }
    SEAM(2);

    if (IN(3)) {
        const int gwx = ((G % 8 == 0) ? (bid % 8) * (G / 8) + bid / 8 : bid) * 8 + wave;
        for (int r = gwx; r < MT; r += NGW) {
            { const f32x4 a0 = *(const f32x4*)(SSA + (size_t)r * 8), a1 = *(const f32x4*)(SSA + (size_t)r * 8 + 4);
              const float ra = rsqrtf(((a0[0] + a0[1]) + (a0[2] + a0[3]) + (a1[0] + a1[1]) + (a1[2] + a1[3])) * (1.f / 1024.f) + EPS);
              bf16_t* mp = MIX + (size_t)r * DM + lane * 16;
              u32x4 m0 = *(const u32x4*)mp, m1 = *(const u32x4*)(mp + 8);
#pragma unroll
              for (int i = 0; i < 4; ++i) { m0[i] = cvtpk(bflo(m0[i]) * ra, bfhi(m0[i]) * ra); m1[i] = cvtpk(bflo(m1[i]) * ra, bfhi(m1[i]) * ra); }
              *(u32x4*)mp = m0; *(u32x4*)(mp + 8) = m1; }
            int t, b; const bool smp = r >= NPR;
            if (!smp) { t = r & (SEQ - 1); b = r >> 13; } else { t = (r - NPR) & 63; b = (r - NPR) >> 6; }
            const int ch = lane * 16;
            float cu0[16], cu1[16], cu2[16], bv[16];
            { const u32x4 c0 = *(const u32x4*)(CBf + (size_t)r * 1024 + ch), c1 = *(const u32x4*)(CBf + (size_t)r * 1024 + ch + 8);
              const u32x4 b0 = *(const u32x4*)(BBf + (size_t)r * 1024 + ch), b1 = *(const u32x4*)(BBf + (size_t)r * 1024 + ch + 8);
#pragma unroll
              for (int i = 0; i < 4; ++i) { cu0[2 * i] = bflo(c0[i]); cu0[2 * i + 1] = bfhi(c0[i]); cu0[8 + 2 * i] = bflo(c1[i]); cu0[8 + 2 * i + 1] = bfhi(c1[i]);
                  bv[2 * i] = bflo(b0[i]); bv[2 * i + 1] = bfhi(b0[i]); bv[8 + 2 * i] = bflo(b1[i]); bv[8 + 2 * i + 1] = bfhi(b1[i]); } }
#pragma unroll
            for (int k = 1; k <= 2; ++k) {
                float* d = k == 1 ? cu1 : cu2;
                if (t - k >= 0) { const size_t rr = (size_t)(r - k) * 1024 + ch;
                    const u32x4 c0 = *(const u32x4*)(CBf + rr), c1 = *(const u32x4*)(CBf + rr + 8);
#pragma unroll
                    for (int i = 0; i < 4; ++i) { d[2 * i] = bflo(c0[i]); d[2 * i + 1] = bfhi(c0[i]); d[8 + 2 * i] = bflo(c1[i]); d[8 + 2 * i + 1] = bfhi(c1[i]); } }
                else if (smp) { const float* cp = c_conv + ((size_t)b * 2 + (2 + t - k)) * 1024 + ch;
#pragma unroll
                    for (int i = 0; i < 16; ++i) d[i] = cp[i]; }
                else {
#pragma unroll
                    for (int i = 0; i < 16; ++i) d[i] = 0.f; }
            }
            float ss = 0.f; unsigned ow[8];
#pragma unroll
            for (int cc = 0; cc < 16; ++cc) { const float cv = w_cmix[ch + cc] * cu2[cc] + w_cmix[1024 + ch + cc] * cu1[cc] + w_cmix[2048 + ch + cc] * cu0[cc]; bv[cc] *= cv; ss += bv[cc] * bv[cc]; }
            const float rbn = rsqrtf(wave_sum(ss) * (1.f / 1024.f) + EPS);
#pragma unroll
            for (int i = 0; i < 8; ++i) ow[i] = cvtpk(bv[2 * i] * rbn, bv[2 * i + 1] * rbn);
            *(u32x4*)(MIX + (size_t)r * DM + 1024 + ch) = (u32x4){ow[0], ow[1], ow[2], ow[3]}; *(u32x4*)(MIX + (size_t)r * DM + 1024 + ch + 8) = (u32x4){ow[4], ow[5], ow[6], ow[7]};
            float* cvo = nullptr;
            if (!smp) { if (t >= SEQ - 2) cvo = o_pc + ((size_t)b * 2 + (t - (SEQ - 2))) * 1024; } else if (t >= 62) cvo = o_sc + ((size_t)b * 2 + (t - 62)) * 1024;
            if (cvo) {
#pragma unroll
                for (int i = 0; i < 4; ++i) *(f32x4*)(cvo + ch + 4 * i) = (f32x4){cu0[4 * i], cu0[4 * i + 1], cu0[4 * i + 2], cu0[4 * i + 3]}; }
        }
    }
    SEAM(3);

    if (IN(4)) {
        Order S; S.init(MT, DM, G, bid);
        EpiP3 E{XCH, x_p, x_s, HB, SS2};
        gemm_phase<EpiP3>(lds, MIX, WOUT, MIX, WOUT, DM, S, E);
    }
    SEAM(4);

    if (IN(5)) {
        Order S; S.init(MT, 1024, G, bid);
        EpiP4 E{XCH, SS2, g_xq, QX, 0.0625f * LOG2E};
        gemm_phase<EpiP4>(lds, HB, WXQ, HB, WXQ, DM, S, E);
    }
    SEAM(5);

    if (IN(6)) {
        float gm1 = fmaxf(fmaxf(fabsf(g_xq[lane]), fabsf(g_xq[lane + 64])), fmaxf(fabsf(g_xq[lane + 128]), fabsf(g_xq[lane + 192])));
        float gm2 = fmaxf(fmaxf(fabsf(g_xk[lane]), fabsf(g_xk[lane + 64])), fmaxf(fabsf(g_xk[lane + 128]), fabsf(g_xk[lane + 192])));
        const float cinit = -(16.f * wave_max(gm1) * wave_max(gm2) * 1.01f) * LOG2E;
        for (int un = bid; un < 1024 + 128; un += G) {
            size_t krow0, qrow0; int h, nq;
            if (un < 1024) { const int qt = un >> 2; h = un & 3; krow0 = (size_t)(qt >> 6) * 256; qrow0 = (size_t)qt * 128; nq = 128; }
            else { const int su = un - 1024, b = su >> 2; h = su & 3; krow0 = (size_t)(4 + b) * 256; qrow0 = (size_t)NPR + 64 * b; nq = 64; }
            attn_unit<2, 1, false>(lds, MKA + krow0 * 1024, MVA + krow0 * 1024, h * 256, 8, QX + qrow0 * 1024, nq, XO + qrow0 * 1024, 1024, nullptr, 0, 0, (const LAS float*)(lds + BT_OFF), cinit);
        }
    }
    SEAM(6);

    if (IN(7)) {
        Order S; S.init(MT, DM, G, bid);
        EpiP6 E{XCH, H2B, SS3};
        gemm_phase<EpiP6>(lds, XO, WXO, XO, WXO, 1024, S, E);
    }
    SEAM(7);

    if (IN(8)) {
        Order S; S.init(MT, 2 * DFF, G, bid);
        EpiP7 E{XCH, SS3, GATE, o_pf, o_sf, c_ffn, w_fconv, TAILB, HEADU, HEADG};
        gemm_phase<EpiP7>(lds, H2B, WUG, H2B, WUG, DM, S, E);
    }
    SEAM(8);

    if (IN(9)) {
        for (int it = gw; it < 128 * 11; it += NGW) {
            const int pm = it / 11, sl = it % 11, f = sl * 512 + lane * 8;
            if ((pm & 31) == 0) continue;
            const float* t0 = TAILB + ((size_t)(pm - 1) * 2) * DFF + f; const float* hu = HEADU + ((size_t)pm * 2) * DFF + f; const float* hg = HEADG + ((size_t)pm * 2) * DFF + f;
            float a0[8], a1[8];
#pragma unroll
            for (int i = 0; i < 8; ++i) { const float x2 = t0[i], x1 = t0[DFF + i], c0 = hu[i], c1 = hu[DFF + i];
                const float w0 = w_fconv[f + i], w1 = w_fconv[DFF + f + i], w2 = w_fconv[2 * DFF + f + i];
                a0[i] = silu_mul(w0 * x2 + w1 * x1 + w2 * c0, hg[i]); a1[i] = silu_mul(w0 * x1 + w1 * c0 + w2 * c1, hg[DFF + i]); }
            *(u32x4*)(GATE + (size_t)pm * BM * DFF + f) = (u32x4){cvtpk(a0[0], a0[1]), cvtpk(a0[2], a0[3]), cvtpk(a0[4], a0[5]), cvtpk(a0[6], a0[7])};
            *(u32x4*)(GATE + ((size_t)pm * BM + 1) * DFF + f) = (u32x4){cvtpk(a1[0], a1[1]), cvtpk(a1[2], a1[3]), cvtpk(a1[4], a1[5]), cvtpk(a1[6], a1[7])};
        }
    }
    SEAM(9);

    if (IN(10)) {
        Order S; S.init(MT, DM, G, bid, 0, 1, 1024, 4);
        EpiP9 E{Y, H2B, (float*)(ws + WS_UP)};
        gemm_phase<EpiP9>(lds, GATE, WDN, GATE, WDN, DFF, S, E);
    }
    SEAM(10);

    if (IN(11)) {
        Order S; S.init(MT, DM, G, bid, 0, 1, 1024, 4);
        const float* PART = (const float*)(ws + WS_UP);
        for (int wi = gw; wi < 64 * 256; wi += NGW) { const int tl = wi >> 8, row = wi & 255; int pm, pn; S.map(1024 + tl, pm, pn);
            const unsigned off = (unsigned)(pm * BM + row) * DM + pn * BM + lane * 4;
            const u32x2 h = *(const u32x2*)(H2B + off);
            const float* pp = PART + (size_t)tl * 4 * 65536 + row * 256 + lane * 4;
            const f32x4 p0 = *(const f32x4*)pp, p1 = *(const f32x4*)(pp + 65536), p2 = *(const f32x4*)(pp + 2 * 65536), p3 = *(const f32x4*)(pp + 3 * 65536);
            *(f32x4*)(Y + off) = (f32x4){bflo(h.x), bfhi(h.x), bflo(h.y), bfhi(h.y)} + ((p0 + p1) + (p2 + p3)); }
    }
#undef IN
#undef SEAM
}

extern "C" void kernel_launch(void* const* d_in, const int* in_sizes, int n_in, void* d_out, int out_size, void* d_ws, size_t ws_size, hipStream_t stream) {
    static int grid = 0;
    if (grid == 0) {
        int dev = 0, cus = 0, per_cu = 0;
        if (n_in != 30 || ws_size < WS_END) { fprintf(stderr, "kernel_launch: unexpected n_in %d or ws %zu\n", n_in, ws_size); grid = -1; return; }
        (void)hipGetDevice(&dev);
        (void)hipDeviceGetAttribute(&cus, hipDeviceAttributeMultiprocessorCount, dev);
        (void)hipFuncSetAttribute((const void*)fwd_kernel, hipFuncAttributeMaxDynamicSharedMemorySize, LDS_BYTES);
        (void)hipOccupancyMaxActiveBlocksPerMultiprocessor(&per_cu, (const void*)fwd_kernel, 512, LDS_BYTES);
        if (per_cu < 1) per_cu = 1;
        grid = cus * per_cu;
    }
    if (grid < 0) return;
    #ifdef PROBE_PH
    (void)hipMemsetAsync(d_ws, 0, 65536, stream);
#else
    (void)hipMemsetAsync(d_ws, 0, 16384, stream);
#endif
    Args a{};
    for (int i = 0; i < 30; ++i) a.in[i] = (const float*)d_in[i];
    a.out = (float*)d_out; a.ws = (unsigned char*)d_ws; a.ph_lo = 0; a.ph_hi = 12;
    void* args[] = {&a};
#ifdef PROBE_PH
    a.ph_hi = PROBE_PH + 1;
    (void)hipLaunchCooperativeKernel((const void*)fwd_kernel, dim3(grid), dim3(512), args, LDS_BYTES, stream);
    for (int r = 0; r < PROBE_N; ++r) { a.ph_lo = PROBE_PH; a.ph_hi = PROBE_PH + 1; a.li = 1 + r; (void)hipLaunchCooperativeKernel((const void*)fwd_kernel, dim3(grid), dim3(512), args, LDS_BYTES, stream); }
    a.ph_lo = PROBE_PH + 1; a.ph_hi = 12; a.li = 1 + PROBE_N;
#endif
    hipError_t e = hipLaunchCooperativeKernel((const void*)fwd_kernel, dim3(grid), dim3(512), args, LDS_BYTES, stream);
    if (e != hipSuccess) fprintf(stderr, "cooperative launch failed: %s (grid %d)\n", hipGetErrorString(e), grid);
}
```
